# Optimizing an MI355X kernel written in HIP

```python
import jax, jax.numpy as jnp
from jax import lax
import numpy as np

D_MODEL = 2048
BATCH = 2
SEQ = 8192
DEPTH = 1

POOL_WINDOWS = (2, 4, 8, 16)
POOL_GROUPS = len(POOL_WINDOWS)
POOL_GROUP_WIDTH = D_MODEL // 8
POOL_WIDTH = POOL_GROUPS * POOL_GROUP_WIDTH
LRU_WIDTH = D_MODEL
LRU_BLOCK_WIDTH = 256
LRU_BLOCKS = LRU_WIDTH // LRU_BLOCK_WIDTH
LRU_CONV_WIDTH = 4
LRU_C = 8.0
LRU_A_MIN = 0.9
LRU_A_MAX = 0.999
N_BRANCHES = 2
IN_WIDTH = POOL_WIDTH + 2 * LRU_WIDTH + N_BRANCHES * D_MODEL
D_FF = 3 * D_MODEL
FFN_CONV_WIDTH = 3
EPS = 1e-6

kernel_name = "hybrid_pool_rglru_gated_block"


def rms_norm(x, g):
    xf = x.astype(jnp.float32)
    y = xf * lax.rsqrt(jnp.mean(xf * xf, axis=-1, keepdims=True) + EPS)
    return (y * g.astype(jnp.float32)).astype(x.dtype)


def causal_depthwise_conv(x, w, b):
    K = w.shape[0]
    S = x.shape[1]
    xp = jnp.pad(x, ((0, 0), (K - 1, 0), (0, 0)))
    out = b
    for k in range(K):
        out = out + xp[:, k:k + S] * w[k]
    return out


def pool_mixer(u, w_pool, pool_scale):
    B, S, _ = u.shape
    uf = u.astype(jnp.float32)
    c = jnp.cumsum(uf, axis=1)
    pos = jnp.arange(1, S + 1, dtype=jnp.float32)
    means = []
    for g, w in enumerate(POOL_WINDOWS):
        cg = c[..., g * POOL_GROUP_WIDTH:(g + 1) * POOL_GROUP_WIDTH]
        shifted = jnp.pad(cg, ((0, 0), (w, 0), (0, 0)))[:, :S]
        count = jnp.minimum(pos, float(w))[None, :, None]
        means.append((cg - shifted) / count)
    mean = jnp.stack(means, axis=2)
    d = (mean - uf.reshape(B, S, POOL_GROUPS, POOL_GROUP_WIDTH)).astype(u.dtype)
    y = jnp.einsum('bsgc,gcd->bsgd', d, w_pool).reshape(B, S, POOL_WIDTH)
    return y * pool_scale


def rg_lru(x, w_a, b_a, w_i, b_i, lam):
    B, S, R = x.shape
    xb = x.reshape(B, S, LRU_BLOCKS, LRU_BLOCK_WIDTH)
    r = jax.nn.sigmoid(jnp.einsum('bshc,hcd->bshd', xb, w_a).reshape(B, S, R) + b_a)
    i = jax.nn.sigmoid(jnp.einsum('bshc,hcd->bshd', xb, w_i).reshape(B, S, R) + b_i)
    log_a = -LRU_C * r.astype(jnp.float32) * jax.nn.softplus(-lam.astype(jnp.float32))
    a = jnp.exp(log_a)
    mult = jnp.sqrt(-jnp.expm1(2.0 * log_a))
    bx = mult * (i * x).astype(jnp.float32)

    def combine(left, right):
        a1, b1 = left
        a2, b2 = right
        return a1 * a2, a2 * b1 + b2

    _, h = lax.associative_scan(combine, (a, bx), axis=1)
    return h.astype(x.dtype)


def setup_inputs(seed: int = 0) -> dict:
    key = jax.random.key(seed)
    ks = jax.random.split(key, 24)
    f32 = jnp.float32

    def nrm(k, shape, fan_in):
        return jax.random.normal(k, shape, f32) * (fan_in ** -0.5)

    def gain(k, shape):
        return 1.0 + 0.02 * jax.random.normal(k, shape, f32)

    def bias(k, shape):
        return 0.01 * jax.random.normal(k, shape, f32)

    L = DEPTH
    u = jax.random.uniform(ks[12], (L, LRU_WIDTH), f32, LRU_A_MIN, LRU_A_MAX)
    s = u ** (1.0 / LRU_C)
    lru_lambda = jnp.log(s) - jnp.log1p(-s)
    return {
        "x": jax.random.normal(ks[0], (BATCH, SEQ, D_MODEL), f32),
        "g_mix": gain(ks[1], (L, D_MODEL)),
        "w_in": nrm(ks[2], (L, D_MODEL, IN_WIDTH), D_MODEL),
        "b_gate": bias(ks[3], (L, N_BRANCHES * D_MODEL)),
        "w_pool": nrm(ks[4], (L, POOL_GROUPS, POOL_GROUP_WIDTH, POOL_GROUP_WIDTH), POOL_GROUP_WIDTH),
        "pool_scale": gain(ks[5], (L, POOL_WIDTH)),
        "lru_conv_w": nrm(ks[6], (L, LRU_CONV_WIDTH, LRU_WIDTH), LRU_CONV_WIDTH),
        "lru_conv_b": bias(ks[7], (L, LRU_WIDTH)),
        "w_a": nrm(ks[8], (L, LRU_BLOCKS, LRU_BLOCK_WIDTH, LRU_BLOCK_WIDTH), LRU_BLOCK_WIDTH),
        "b_a": bias(ks[9], (L, LRU_WIDTH)),
        "w_i": nrm(ks[10], (L, LRU_BLOCKS, LRU_BLOCK_WIDTH, LRU_BLOCK_WIDTH), LRU_BLOCK_WIDTH),
        "b_i": bias(ks[11], (L, LRU_WIDTH)),
        "lru_lambda": lru_lambda,
        "w_pool_proj": nrm(ks[13], (L, POOL_WIDTH, D_MODEL), POOL_WIDTH),
        "w_lru_proj": nrm(ks[14], (L, LRU_WIDTH, D_MODEL), LRU_WIDTH),
        "w_out": nrm(ks[15], (L, D_MODEL, D_MODEL), D_MODEL),
        "g_mlp": gain(ks[16], (L, D_MODEL)),
        "w_up": nrm(ks[17], (L, D_MODEL, 2 * D_FF), D_MODEL),
        "ffn_conv_w": nrm(ks[18], (L, FFN_CONV_WIDTH, D_FF), FFN_CONV_WIDTH),
        "ffn_conv_b": bias(ks[19], (L, D_FF)),
        "w_down": nrm(ks[20], (L, D_FF, D_MODEL), D_FF),
        "g_final": gain(ks[21], (D_MODEL,)),
    }


def reference(x, g_mix, w_in, b_gate, w_pool, pool_scale, lru_conv_w, lru_conv_b,
              w_a, b_a, w_i, b_i, lru_lambda, w_pool_proj, w_lru_proj, w_out,
              g_mlp, w_up, ffn_conv_w, ffn_conv_b, w_down, g_final):
    B, S, D = x.shape
    for l in range(DEPTH):
        h = rms_norm(x, g_mix[l])
        proj = h @ w_in[l]
        p0 = POOL_WIDTH
        p1 = p0 + LRU_WIDTH
        p2 = p1 + LRU_WIDTH
        u_pool = proj[..., :p0]
        u_lru = proj[..., p0:p1]
        u_gelu = proj[..., p1:p2]
        gates = jax.nn.sigmoid(proj[..., p2:] + b_gate[l]).reshape(B, S, N_BRANCHES, D)

        y_pool = pool_mixer(u_pool, w_pool[l], pool_scale[l])
        v = causal_depthwise_conv(u_lru, lru_conv_w[l], lru_conv_b[l])
        y_lru = rg_lru(v, w_a[l], b_a[l], w_i[l], b_i[l], lru_lambda[l]) * jax.nn.gelu(u_gelu)

        merged = (gates[:, :, 0] * (y_pool @ w_pool_proj[l])
                  + gates[:, :, 1] * (y_lru @ w_lru_proj[l]))
        x = x + merged @ w_out[l]

        h2 = rms_norm(x, g_mlp[l])
        up = h2 @ w_up[l]
        gate_pre = up[..., :D_FF]
        val = up[..., D_FF:]
        gate = jax.nn.gelu(causal_depthwise_conv(gate_pre, ffn_conv_w[l], ffn_conv_b[l]))
        x = x + (gate * val) @ w_down[l]
    return rms_norm(x, g_final)
```

```cpp
#include <hip/hip_runtime.h>
#include <hip/hip_cooperative_groups.h>
#include <cstdio>
#include <cstdint>
namespace cg = cooperative_groups;

#define LAS __attribute__((address_space(3)))
typedef unsigned short bf16_t;
typedef short bf16x8 __attribute__((ext_vector_type(8)));
typedef float f32x4 __attribute__((ext_vector_type(4)));
typedef float f32x2 __attribute__((ext_vector_type(2)));
typedef unsigned u32x4 __attribute__((ext_vector_type(4)));
typedef unsigned u32x2 __attribute__((ext_vector_type(2)));

constexpr int M = 16384, SEQ = 8192, D = 2048, PW = 1024, LW = 2048, INW = 9216, FF = 6144, KC = PW + LW;
constexpr float EPS = 1e-6f;
constexpr int NWG = 256, NTHR = 512, NT = NWG * NTHR, NWV = NT / 64;
constexpr int CH_L = 128, NCH = SEQ / CH_L;

constexpr size_t MiB = 1u << 20;
constexpr size_t WS_RSTD1 = 0, WS_SS2 = 64 * 1024, WS_SS3 = 128 * 1024, WS_SP8 = 192 * 1024;
constexpr size_t WS_BAR = 256 * 1024;
constexpr size_t WS_CNT = 320 * 1024;
constexpr size_t WS_AGGP = 1 * MiB, WS_AGGH = 2 * MiB;
constexpr size_t WS_WT_POOL = 4 * MiB;
constexpr size_t WS_WT_GATE = WS_WT_POOL + MiB / 2;
constexpr size_t WS_WT_PP = WS_WT_GATE + 2 * MiB;
constexpr size_t WS_WT_LP = WS_WT_PP + 4 * MiB;
constexpr size_t WS_WT_OUT = WS_WT_LP + 8 * MiB;
constexpr size_t WS_XB = 27 * MiB;
constexpr size_t WS_WT_IN = 91 * MiB;
constexpr size_t WS_DD = 27 * MiB;
constexpr size_t WS_V = 59 * MiB;
constexpr size_t WS_YLRU = 59 * MiB;
constexpr size_t WS_UPOOL = 127 * MiB;
constexpr size_t WS_YPOOL = 127 * MiB;
constexpr size_t WS_GELU = 159 * MiB;
constexpr size_t WS_X1B = 159 * MiB;
constexpr size_t WS_GATES = 223 * MiB;
constexpr size_t WS_WT_UP = 223 * MiB;
constexpr size_t WS_WT_DOWN = 271 * MiB;
constexpr size_t WS_ULRU = 351 * MiB;
constexpr size_t WS_BX = 351 * MiB;
constexpr size_t WS_V2 = 287 * MiB;
constexpr size_t WS_HEADU = 447 * MiB, WS_TAILU = 453 * MiB;
constexpr size_t WS_YCAT = 351 * MiB;
constexpr size_t WS_MERGED = 447 * MiB;
constexpr size_t WS_ACT = 295 * MiB;
constexpr size_t WS_TAILG = 27 * MiB, WS_HEADG = 39 * MiB, WS_HEADV = 51 * MiB;
constexpr size_t WS_END = 511 * MiB;

constexpr int LDS_BYTES = 131072 + 4096;

__device__ __forceinline__ unsigned cvt_pk_bf16(float lo, float hi) { unsigned r; asm volatile("v_cvt_pk_bf16_f32 %0, %1, %2" : "=v"(r) : "v"(lo), "v"(hi)); return r; }
__device__ __forceinline__ float bf_lo(unsigned w) { return __uint_as_float(w << 16); }
__device__ __forceinline__ float bf_hi(unsigned w) { return __uint_as_float(w & 0xffff0000u); }
__device__ __forceinline__ float sigmoidf_(float x) { return __builtin_amdgcn_rcpf(1.0f + __builtin_amdgcn_exp2f(-1.4426950409f * x)); }
__device__ __forceinline__ float gelu_tanh(float x) {
    const float u = x * (1.5957691216f + 0.0713548163f * x * x);
    return x * __builtin_amdgcn_rcpf(1.0f + __builtin_amdgcn_exp2f(-1.4426950409f * u));
}
__device__ __forceinline__ f32x4 gelu4(f32x4 x) {
    const f32x4 u = x * (x * x * (-0.10294324f) + (-2.3022082f));
    f32x4 e;
#pragma unroll
    for (int j = 0; j < 4; ++j) e[j] = __builtin_amdgcn_exp2f(u[j]);
    const f32x4 d = e + 1.0f; f32x4 r;
#pragma unroll
    for (int j = 0; j < 4; ++j) r[j] = __builtin_amdgcn_rcpf(d[j]);
    return x * r;
}
__device__ __forceinline__ f32x4 sigmoid4(f32x4 x) {
    const f32x4 u = x * (-1.4426950409f); f32x4 e;
#pragma unroll
    for (int j = 0; j < 4; ++j) e[j] = __builtin_amdgcn_exp2f(u[j]);
    const f32x4 d = e + 1.0f; f32x4 r;
#pragma unroll
    for (int j = 0; j < 4; ++j) r[j] = __builtin_amdgcn_rcpf(d[j]);
    return r;
}
__device__ __forceinline__ float wave_sum(float v) {
#pragma unroll
    for (int o = 1; o < 64; o <<= 1) v += __shfl_xor(v, o);
    return v;
}
#define LDS_WAIT() asm volatile("s_waitcnt lgkmcnt(0)" ::: "memory")


#define XB_TMO      128
#define XB_XCNT(j)  (256  + 64 * (j))
#define XB_XSUB(j)  (1280 + 64 * (j))
#define XB_XGEN(j)  (2304 + 64 * (j))
#define XB_TOP      3328
#define XB_TOPGEN   3392
#define XCD_BAR_WORDS 3456
#define XB_SPIN_CAP (1u << 20)
__device__ __forceinline__ unsigned xb_ld(unsigned* p)              { return __hip_atomic_load(p, __ATOMIC_RELAXED, __HIP_MEMORY_SCOPE_AGENT); }
__device__ __forceinline__ unsigned xb_add(unsigned* p, unsigned v) { return __hip_atomic_fetch_add(p, v, __ATOMIC_RELAXED, __HIP_MEMORY_SCOPE_AGENT); }
__device__ __forceinline__ unsigned xb_xcc_id() { return (unsigned)__builtin_amdgcn_s_getreg((3 << 11) | 20) & 0xFu; }
#define XB_SPIN(cond, bar) do { unsigned _sp = 0; while (cond) { __builtin_amdgcn_s_sleep(1); \
    if ((++_sp & 255u) == 0u) { if (xb_ld(&(bar)[XB_TMO])) break; if (_sp > XB_SPIN_CAP) { atomicAdd(&(bar)[XB_TMO], 1u); break; } } } } while (0)
struct XcdBarrier { unsigned* bar; unsigned x; volatile LAS unsigned* st; };
__device__ __forceinline__ XcdBarrier xcd_barrier_post(unsigned* bar, volatile LAS unsigned* st) {
    XcdBarrier b; b.bar = bar; b.x = xb_xcc_id(); b.st = st;
    if (threadIdx.x == 0) (void)xb_add(&bar[XB_XCNT(b.x)], 1u);
    return b;
}
__device__ __forceinline__ void xcd_barrier_complete(unsigned* bar, unsigned x, unsigned& nloc, unsigned& nx) {
    const unsigned G = gridDim.x * gridDim.y * gridDim.z;
    unsigned sum, cnt, mine, sp = 0u;
    for (;;) {
        sum = 0u; cnt = 0u; mine = 0u;
#pragma unroll
        for (unsigned j = 0; j < 16; ++j) { const unsigned c = xb_ld(&bar[XB_XCNT(j)]); sum += c; cnt += (c > 0u) ? 1u : 0u; mine = (j == x) ? c : mine; }
        if (sum == G) break;
        __builtin_amdgcn_s_sleep(1);
        if ((++sp & 255u) == 0u) { if (xb_ld(&bar[XB_TMO])) break; if (sp > XB_SPIN_CAP) { atomicAdd(&bar[XB_TMO], 1u); break; } }
    }
    nloc = mine > 0u ? mine : 1u; nx = cnt > 0u ? cnt : 1u;
}
__device__ __forceinline__ void xcd_barrier(const XcdBarrier& b) {
    asm volatile("s_waitcnt vmcnt(0)" ::: "memory");
    __syncthreads();
    if (threadIdx.x == 0) {
        unsigned* bar = b.bar;
        __builtin_amdgcn_s_waitcnt(0);
        unsigned nloc = b.st[0], nx = b.st[1];
        if (nloc == 0u) { xcd_barrier_complete(bar, b.x, nloc, nx); b.st[0] = nloc; b.st[1] = nx; }
        const unsigned old = xb_add(&bar[XB_XSUB(b.x)], 1u);
        const unsigned gen = old / nloc;
        if (old + 1u == (gen + 1u) * nloc) {
            __builtin_amdgcn_fence(__ATOMIC_RELEASE, "agent");
            asm volatile("s_waitcnt vmcnt(0)" ::: "memory");
            const unsigned og = xb_add(&bar[XB_TOP], 1u);
            const unsigned tg = og / nx;
            if (og + 1u == (tg + 1u) * nx) xb_add(&bar[XB_TOPGEN], 1u);
            else XB_SPIN(xb_ld(&bar[XB_TOPGEN]) == tg, bar);
            __builtin_amdgcn_fence(__ATOMIC_ACQUIRE, "agent");
            xb_add(&bar[XB_XGEN(b.x)], 1u);
            asm volatile("s_waitcnt vmcnt(0)" ::: "memory");
        } else {
            XB_SPIN(xb_ld(&bar[XB_XGEN(b.x)]) == gen, bar);
            __builtin_amdgcn_fence(__ATOMIC_ACQUIRE, "agent");
            asm volatile("s_waitcnt vmcnt(0)" ::: "memory");
        }
    }
    __syncthreads();
}

namespace pg8 {
constexpr int BM = 256, BK = 64, HALF = 128, HTB = HALF * BK * 2, STAGE_BYTES = 8 * HTB, NXCD = 8, WGM = 2;
__host__ __device__ __forceinline__ int lds_byte(int r, int c) { const int st = (r >> 4) * 2 + (c >> 5), rr = r & 15, cc = c & 31, ob = rr * 64 + cc * 2; return st * 1024 + (ob ^ (((ob >> 9) & 1) << 5)); }
__host__ __device__ __forceinline__ void stage_rc(int b, int& R, int& C) { const int st = b / 1024, sb = b % 1024, swz = sb ^ (((sb >> 9) & 1) << 5); R = (st >> 1) * 16 + swz / 64; C = (st & 1) * 32 + (swz % 64) / 2; }
__host__ __device__ __forceinline__ int perm32(int rho) { const int n = rho >> 4, i = rho & 15; return 8 * (i >> 2) + 4 * n + (i & 3); }

struct Unit { int pm, pn; };
struct Gemm { const bf16_t* A; const bf16_t* Bt; int lda, K, agrp; };

struct StaticOrder {
    int nM, nN, nwg, G, c;
    __device__ void init(int M_, int N_, int G_, int c_) { nM = M_ / BM; nN = N_ / BM; nwg = nM * nN; G = G_; c = c_; }
    __device__ bool next(int i, Unit& u) const {
        const long L = (long)i * G + c; if (L >= nwg) return false;
        int wgid = (int)L; { const int q = nwg / NXCD, r = nwg % NXCD, xcd = wgid % NXCD, off = wgid / NXCD; wgid = (xcd < r ? xcd * (q + 1) : r * (q + 1) + (xcd - r) * q) + off; }
        const int nig = WGM * nN, gid = wgid / nig, fm = gid * WGM, gsz = (nM - fm) < WGM ? (nM - fm) : WGM;
        u.pm = fm + ((wgid % nig) % gsz); u.pn = (wgid % nig) / gsz; return true;
    }
};

struct Order2D {
    int c, nbn, nrounds, tail;
    __device__ void init(int M_, int N_, int c_) { c = c_; nbn = (N_ / BM) / 16; nrounds = ((M_ / BM) / 16) * nbn; tail = ((N_ / BM) % 16) ? 1 : 0; }
    __device__ bool next(int i, Unit& u) const {
        const int x = c & 7, j = c >> 3;
        if (i >= nrounds) { if (i >= nrounds + tail) return false; u.pm = 8 * x + (j & 7); u.pn = 16 * nbn + (j >> 3); return true; }
        const int xr = x & 3, xc = x >> 2, bm = i / nbn, bn = i % nbn;
        u.pm = 16 * bm + 4 * xr + (j & 3); u.pn = 16 * bn + 8 * xc + (j >> 2); return true;
    }
};
struct PanelOrder {
    int c;
    __device__ bool next(int i, Unit& u) const { if (i >= 2) return false; const int x = c & 7, j = c >> 3; u.pm = 8 * x + (j >> 3) + 4 * i; u.pn = j & 7; return true; }
};

template <class Epi, class Sched>
__device__ __forceinline__ void gemm_phase(LAS unsigned char* lds, const Gemm g, const Sched& S, const Epi& E) {
    int tid = threadIdx.x; asm volatile("" : "+v"(tid));
    const int wid = __builtin_amdgcn_readfirstlane(tid >> 6), lane = tid & 63, wr = wid >> 2, wc = wid & 3, fr = lane & 15, fq = lane >> 4;
    const int K = g.K, nt = K / BK, lda = g.lda;
    unsigned voffA[2], voffB[2];
#pragma unroll
    for (int i = 0; i < 2; ++i) { int R, C; stage_rc(tid * 16 + i * 8192, R, C); const int Rb = (R & ~31) + perm32(R & 31);
        voffA[i] = (unsigned)(R * lda + C) * 2u; voffB[i] = (unsigned)(Rb * K + C) * 2u; }
    const size_t kstep = (size_t)(BK * 2);
    const size_t hstepA = (size_t)HALF * lda * 2, tstepA = 2 * hstepA;
    const size_t hstepB = (size_t)HALF * K * 2, tstepB = 2 * hstepB;
    const unsigned ldsw = (unsigned)wid * 1024u;
    const int aoff = lds_byte(wr * 64 + fr, fq * 8), boff = lds_byte(wc * 32 + fr, fq * 8);
#define PG8_SA(b, h) (((b) * 2 + (h)) * HTB)
#define PG8_SB(b, h) ((4 + (b) * 2 + (h)) * HTB)
#define PG8_STAGE(bufoff, gbase, voff) do { _Pragma("unroll") for (int _i = 0; _i < 2; ++_i) \
        __builtin_amdgcn_global_load_lds((const unsigned*)((const char*)(gbase) + (voff)[_i]), (LAS unsigned*)(lds + (bufoff) + ldsw + _i * 8192), 16, 0, 0); } while (0)
#define PG8_LDA(dst, b, h) do { _Pragma("unroll") for (int m = 0; m < 4; ++m) _Pragma("unroll") for (int k = 0; k < 2; ++k) dst[m][k] = *(const LAS bf16x8*)(lds + PG8_SA(b, h) + aoff + m * 2048 + k * 1024); } while (0)
#define PG8_LDB(dst, b, h) do { _Pragma("unroll") for (int n = 0; n < 2; ++n) _Pragma("unroll") for (int k = 0; k < 2; ++k) dst[n][k] = *(const LAS bf16x8*)(lds + PG8_SB(b, h) + boff + n * 2048 + k * 1024); } while (0)
#define PG8_MMA(ai, bj, At, Bt) do { __builtin_amdgcn_s_setprio(1); _Pragma("unroll") for (int m = 0; m < 4; ++m) _Pragma("unroll") for (int n = 0; n < 2; ++n) _Pragma("unroll") for (int k = 0; k < 2; ++k) \
        acc[ai][bj][m][n] = __builtin_amdgcn_mfma_f32_16x16x32_bf16(Bt[n][k], At[m][k], acc[ai][bj][m][n], 0, 0, 0); __builtin_amdgcn_s_setprio(0); } while (0)
#define PG8_WAIT_V(n) asm volatile("s_waitcnt vmcnt(" #n ")" ::: "memory")
#define PG8_WAIT_L(n) asm volatile("s_waitcnt lgkmcnt(" #n ")" ::: "memory")
#define PG8_BAR __builtin_amdgcn_s_barrier()
#define PG8_SCHED __builtin_amdgcn_sched_barrier(0)
#define PG8_ABASE(u) ((const char*)g.A + (size_t)(u).pm * tstepA + (g.agrp ? (size_t)((u).pn / g.agrp) * 512 : (size_t)0))
#define PG8_BBASE(u) ((const char*)g.Bt + (size_t)(u).pn * tstepB)
    Unit cur, nxt; int ui = 0;
    if (!S.next(0, cur)) return;
    f32x4 acc[2][2][4][2];
#pragma unroll
    for (int a = 0; a < 2; ++a)
#pragma unroll
        for (int b = 0; b < 2; ++b)
#pragma unroll
            for (int m = 0; m < 4; ++m)
#pragma unroll
                for (int n = 0; n < 2; ++n) acc[a][b][m][n] = (f32x4){0.f, 0.f, 0.f, 0.f};
    bf16x8 At[4][2], B0[2][2], B1[2][2];
    const char* cA = PG8_ABASE(cur); const char* cB = PG8_BBASE(cur);
    PG8_STAGE(PG8_SB(0, 0), cB, voffB); PG8_STAGE(PG8_SB(0, 1), cB + hstepB, voffB); PG8_STAGE(PG8_SA(0, 0), cA, voffA); PG8_STAGE(PG8_SA(0, 1), cA + hstepA, voffA);
    if (wr == 1) PG8_BAR;
    PG8_WAIT_V(2); PG8_BAR;
    PG8_STAGE(PG8_SB(1, 0), cB + kstep, voffB); PG8_STAGE(PG8_SA(1, 0), cA + kstep, voffA); PG8_STAGE(PG8_SB(1, 1), cB + hstepB + kstep, voffB);
    PG8_WAIT_V(6); PG8_BAR;
    for (;;) {
        const bool has_next = S.next(ui + 1, nxt);
        const char* nA = has_next ? PG8_ABASE(nxt) : cA; const char* nB = has_next ? PG8_BBASE(nxt) : cB;
#pragma unroll 1
        for (int t = 0; t < nt; t += 2) {
            if constexpr (Epi::MIDT >= 0) {
                if (t == Epi::MIDT) { int fr_m = fr, fq_m = fq; asm volatile("" : "+v"(fr_m), "+v"(fq_m)); E.mid(acc, cur, wr, wc, fr_m, fq_m); }
            }
            const bool last = (t == nt - 2);
            const char* a1 = cA + (size_t)(t + 1) * kstep;
            const char* a2 = last ? nA : cA + (size_t)(t + 2) * kstep; const char* b2 = last ? nB : cB + (size_t)(t + 2) * kstep;
            const char* a3 = a2 + kstep; const char* b3 = b2 + kstep;
            PG8_LDB(B0, 0, 0); PG8_LDB(B1, 0, 1); PG8_SCHED; PG8_LDA(At, 0, 0); PG8_STAGE(PG8_SA(1, 1), a1 + hstepA, voffA);
            PG8_WAIT_V(8); PG8_WAIT_L(0); PG8_BAR; PG8_MMA(0, 0, At, B0); PG8_MMA(0, 1, At, B1); PG8_BAR; PG8_SCHED;
            PG8_LDA(At, 0, 1); PG8_STAGE(PG8_SB(0, 0), b2, voffB); PG8_STAGE(PG8_SB(0, 1), b2 + hstepB, voffB); PG8_STAGE(PG8_SA(0, 0), a2, voffA);
            PG8_WAIT_V(8); PG8_WAIT_L(0); PG8_BAR; PG8_MMA(1, 0, At, B0); PG8_MMA(1, 1, At, B1); PG8_BAR; PG8_SCHED;
            PG8_LDB(B0, 1, 0); PG8_LDB(B1, 1, 1); PG8_SCHED; PG8_LDA(At, 1, 0); PG8_STAGE(PG8_SA(0, 1), a2 + hstepA, voffA);
            PG8_WAIT_V(8); PG8_WAIT_L(0); PG8_BAR; PG8_MMA(0, 0, At, B0); PG8_MMA(0, 1, At, B1); PG8_BAR; PG8_SCHED;
            PG8_LDA(At, 1, 1); PG8_STAGE(PG8_SB(1, 0), b3, voffB); PG8_STAGE(PG8_SB(1, 1), b3 + hstepB, voffB); PG8_STAGE(PG8_SA(1, 0), a3, voffA);
            PG8_WAIT_V(8); PG8_WAIT_L(0); PG8_BAR; PG8_MMA(1, 0, At, B0); PG8_MMA(1, 1, At, B1); PG8_BAR; PG8_SCHED;
        }
        if (wr == 0) PG8_BAR;
        { int fr_e = fr, fq_e = fq; asm volatile("" : "+v"(fr_e), "+v"(fq_e));
          E(acc, cur, wr, wc, fr_e, fq_e); }
        if (!has_next) break;
#pragma unroll
        for (int a = 0; a < 2; ++a)
#pragma unroll
            for (int b = 0; b < 2; ++b)
#pragma unroll
                for (int m = 0; m < 4; ++m)
#pragma unroll
                    for (int n = 0; n < 2; ++n) acc[a][b][m][n] = (f32x4){0.f, 0.f, 0.f, 0.f};
        cur = nxt; cA = nA; cB = nB; ++ui;
        if (wr == 1) PG8_BAR;
    }
    PG8_WAIT_V(0);
    PG8_BAR;
#undef PG8_SA
#undef PG8_SB
#undef PG8_STAGE
#undef PG8_LDA
#undef PG8_LDB
#undef PG8_MMA
#undef PG8_WAIT_V
#undef PG8_WAIT_L
#undef PG8_BAR
#undef PG8_SCHED
#undef PG8_ABASE
#undef PG8_BBASE
}
}
using pg8::Unit;

#define EPI_ARGS const f32x4 (&acc)[2][2][4][2], const Unit& u, int wr, int wc, int fr, int fq
#define ROW_OF(ai, m) (u.pm * 256 + (ai) * 128 + wr * 64 + (m) * 16 + fr)

struct EpiProj {
    static constexpr int MIDT = -1;
    const float* zeros; const float* b_gate; bf16_t *upool, *ulru, *gelu_u, *gates;
    const float* cw; const float* cb; bf16_t* vout; float* headu; float* tailu;
    __device__ __forceinline__ void operator()(EPI_ARGS) const {
        const int pn = u.pn;
        if (pn >= 4 && pn < 12) {
            const int lane = fq * 16 + fr, s1 = (lane & 48) | ((fr - 1) & 15), s2 = (lane & 48) | ((fr - 2) & 15), s3 = (lane & 48) | ((fr - 3) & 15);
#pragma unroll
            for (int bj = 0; bj < 2; ++bj) {
                const int c0 = (pn - 4) * 256 + bj * 128 + wc * 32 + 8 * fq;
                f32x4 w0[2], w1[2], w2[2], w3[2], bb[2];
#pragma unroll
                for (int n = 0; n < 2; ++n) { w0[n] = *(const f32x4*)(cw + c0 + 4 * n); w1[n] = *(const f32x4*)(cw + LW + c0 + 4 * n); w2[n] = *(const f32x4*)(cw + 2 * LW + c0 + 4 * n); w3[n] = *(const f32x4*)(cw + 3 * LW + c0 + 4 * n); bb[n] = *(const f32x4*)(cb + c0 + 4 * n); }
#pragma unroll
                for (int ai = 0; ai < 2; ++ai) {
                    const int blk = u.pm * 4 + ai * 2 + wr;
                    f32x4 q1[2], q2[2], q3[2];
#pragma unroll
                    for (int n = 0; n < 2; ++n) { q1[n] = (f32x4){0.f, 0.f, 0.f, 0.f}; q2[n] = q1[n]; q3[n] = q1[n]; }
#pragma unroll
                    for (int m = 0; m < 4; ++m) {
                        const int row = ROW_OF(ai, m);
                        f32x4 o[2];
#pragma unroll
                        for (int n = 0; n < 2; ++n) {
                            const f32x4 gv = acc[ai][bj][m][n];
                            f32x4 r1, r2, r3, p1, p2, p3;
#pragma unroll
                            for (int j = 0; j < 4; ++j) { r1[j] = __shfl(gv[j], s1); r2[j] = __shfl(gv[j], s2); r3[j] = __shfl(gv[j], s3); }
#pragma unroll
                            for (int j = 0; j < 4; ++j) { p1[j] = fr >= 1 ? r1[j] : q1[n][j]; p2[j] = fr >= 2 ? r2[j] : q2[n][j]; p3[j] = fr >= 3 ? r3[j] : q3[n][j]; }
                            q1[n] = r1; q2[n] = r2; q3[n] = r3;
                            o[n] = bb[n] + w0[n] * p3 + w1[n] * p2 + w2[n] * p1 + w3[n] * gv;
                            if (m == 0 && fr < 3) *(f32x4*)(headu + ((size_t)blk * 3 + fr) * LW + c0 + 4 * n) = gv;
                            if (m == 3 && fr >= 13) *(f32x4*)(tailu + ((size_t)blk * 3 + (fr - 13)) * LW + c0 + 4 * n) = gv;
                        }
                        if (!(m == 0 && fr < 3)) {
                            u32x4 w; w.x = cvt_pk_bf16(o[0][0], o[0][1]); w.y = cvt_pk_bf16(o[0][2], o[0][3]); w.z = cvt_pk_bf16(o[1][0], o[1][1]); w.w = cvt_pk_bf16(o[1][2], o[1][3]);
                            __builtin_nontemporal_store(w, (u32x4*)(vout + (size_t)row * LW + c0));
                        }
                    }
                }
            }
            return;
        }
        bf16_t* base; int ldc, colt, mode;
        if (pn < 4) { base = upool; ldc = PW; colt = pn * 256; mode = 0; }
        else if (pn < 12) { base = ulru; ldc = LW; colt = (pn - 4) * 256; mode = 0; }
        else if (pn < 20) { base = gelu_u; ldc = LW; colt = (pn - 12) * 256; mode = 1; }
        else { base = gates; ldc = 2 * D; colt = (pn - 20) * 256; mode = 2; }
        const int col0 = colt + wc * 32 + 8 * fq;
        const float* bsrc = (mode == 2) ? b_gate : zeros;
        f32x4 bv[2][2];
#pragma unroll
        for (int bj = 0; bj < 2; ++bj)
#pragma unroll
            for (int n = 0; n < 2; ++n) bv[bj][n] = *(const f32x4*)(bsrc + col0 + bj * 128 + 4 * n);
#pragma unroll
        for (int ai = 0; ai < 2; ++ai)
#pragma unroll
            for (int m = 0; m < 4; ++m) {
                const int row = ROW_OF(ai, m);
                bf16_t* rowp = base + (size_t)row * ldc + col0;
#pragma unroll
                for (int bj = 0; bj < 2; ++bj) {
                    f32x4 v0 = acc[ai][bj][m][0], v1 = acc[ai][bj][m][1];
                    v0 = v0 + bv[bj][0]; v1 = v1 + bv[bj][1];
                    if (mode == 1) { v0 = gelu4(v0); v1 = gelu4(v1); }
                    else if (mode == 2) { v0 = sigmoid4(v0); v1 = sigmoid4(v1); }
                    if (mode == 2) {
                        v0 = v0 * 255.0f; v1 = v1 * 255.0f; u32x2 w; w.x = 0u; w.y = 0u;
                        w.x = __builtin_amdgcn_cvt_pk_u8_f32(v0[0], 0, w.x); w.x = __builtin_amdgcn_cvt_pk_u8_f32(v0[1], 1, w.x); w.x = __builtin_amdgcn_cvt_pk_u8_f32(v0[2], 2, w.x); w.x = __builtin_amdgcn_cvt_pk_u8_f32(v0[3], 3, w.x);
                        w.y = __builtin_amdgcn_cvt_pk_u8_f32(v1[0], 0, w.y); w.y = __builtin_amdgcn_cvt_pk_u8_f32(v1[1], 1, w.y); w.y = __builtin_amdgcn_cvt_pk_u8_f32(v1[2], 2, w.y); w.y = __builtin_amdgcn_cvt_pk_u8_f32(v1[3], 3, w.y);
                        *(u32x2*)((unsigned char*)gates + (size_t)row * (2 * D) + col0 + bj * 128) = w;
                    } else {
                        u32x4 w; w.x = cvt_pk_bf16(v0[0], v0[1]); w.y = cvt_pk_bf16(v0[2], v0[3]); w.z = cvt_pk_bf16(v1[0], v1[1]); w.w = cvt_pk_bf16(v1[2], v1[3]);
                        __builtin_nontemporal_store(w, (u32x4*)(rowp + bj * 128));
                    }
                }
            }
    }
};

struct EpiPool {
    static constexpr int MIDT = -1;
    const float* pool_scale; bf16_t* ypool;
    __device__ __forceinline__ void operator()(EPI_ARGS) const {
        const int col0 = u.pn * 256 + wc * 32 + 8 * fq;
        f32x4 sc[2][2];
#pragma unroll
        for (int bj = 0; bj < 2; ++bj)
#pragma unroll
            for (int n = 0; n < 2; ++n) sc[bj][n] = *(const f32x4*)(pool_scale + col0 + bj * 128 + 4 * n);
#pragma unroll
        for (int ai = 0; ai < 2; ++ai)
#pragma unroll
            for (int m = 0; m < 4; ++m) {
                bf16_t* rowp = ypool + (size_t)ROW_OF(ai, m) * KC + col0;
#pragma unroll
                for (int bj = 0; bj < 2; ++bj) {
                    const f32x4 v0 = acc[ai][bj][m][0] * sc[bj][0], v1 = acc[ai][bj][m][1] * sc[bj][1];
                    u32x4 w; w.x = cvt_pk_bf16(v0[0], v0[1]); w.y = cvt_pk_bf16(v0[2], v0[3]); w.z = cvt_pk_bf16(v1[0], v1[1]); w.w = cvt_pk_bf16(v1[2], v1[3]);
                    *(u32x4*)(rowp + bj * 128) = w;
                }
            }
    }
};

struct EpiLru {
    static constexpr int MIDT = -1;
    const bf16_t* V; const float* b_a; const float* b_i; const float* sp8; unsigned* AB;
    __device__ __forceinline__ void operator()(EPI_ARGS) const {
        const int c0 = (u.pn >> 1) * 256 + (u.pn & 1) * 128 + wc * 32 + 8 * fq;
        u32x4 vv[2][4];
#pragma unroll
        for (int ai = 0; ai < 2; ++ai)
#pragma unroll
            for (int m = 0; m < 4; ++m) vv[ai][m] = *(const u32x4*)(V + (size_t)ROW_OF(ai, m) * LW + c0);
        f32x4 ba[2], bi[2], sp[2];
#pragma unroll
        for (int n = 0; n < 2; ++n) { ba[n] = *(const f32x4*)(b_a + c0 + 4 * n); bi[n] = *(const f32x4*)(b_i + c0 + 4 * n); sp[n] = *(const f32x4*)(sp8 + c0 + 4 * n); }
#pragma unroll
        for (int ai = 0; ai < 2; ++ai)
#pragma unroll
            for (int m = 0; m < 4; ++m) {
                const int row = ROW_OF(ai, m);
#pragma unroll
                for (int n = 0; n < 2; ++n) {
                    const unsigned w0 = n ? vv[ai][m].z : vv[ai][m].x, w1 = n ? vv[ai][m].w : vv[ai][m].y;
                    const f32x4 vx = (f32x4){bf_lo(w0), bf_hi(w0), bf_lo(w1), bf_hi(w1)};
                    const f32x4 r = sigmoid4(acc[ai][0][m][n] + ba[n]), ig = sigmoid4(acc[ai][1][m][n] + bi[n]);
                    const f32x4 la = sp[n] * r * (-1.4426950409f);
                    f32x4 av;
#pragma unroll
                    for (int j = 0; j < 4; ++j) av[j] = __builtin_amdgcn_exp2f(la[j]);
                    const f32x4 om = 1.0f - av * av; f32x4 sq;
#pragma unroll
                    for (int j = 0; j < 4; ++j) sq[j] = __builtin_amdgcn_sqrtf(om[j]);
                    const f32x4 bx = sq * ig * vx;
                    u32x4 w; w.x = cvt_pk_bf16(la[0], bx[0]); w.y = cvt_pk_bf16(la[1], bx[1]); w.z = cvt_pk_bf16(la[2], bx[2]); w.w = cvt_pk_bf16(la[3], bx[3]);
                    *(u32x4*)(AB + (size_t)row * LW + c0 + 4 * n) = w;
                }
            }
    }
};

#define UNPKG(q, lo, hi) const f32x4 lo = (f32x4){(float)((q).x & 0xff), (float)(((q).x >> 8) & 0xff), (float)(((q).x >> 16) & 0xff), (float)((q).x >> 24)} * (1.0f / 255.0f), hi = (f32x4){(float)((q).y & 0xff), (float)(((q).y >> 8) & 0xff), (float)(((q).y >> 16) & 0xff), (float)((q).y >> 24)} * (1.0f / 255.0f)
#define UNPK4(q, lo, hi) const f32x4 lo = (f32x4){bf_lo((q).x), bf_hi((q).x), bf_lo((q).y), bf_hi((q).y)}, hi = (f32x4){bf_lo((q).z), bf_hi((q).z), bf_lo((q).w), bf_hi((q).w)}
struct EpiMerge {
    static constexpr int MIDT = PW / 64;
    const unsigned char* gates; bf16_t* merged;
    __device__ __forceinline__ void mid(f32x4 (&acc)[2][2][4][2], const Unit& u, int wr, int wc, int fr, int fq) const {
        const int col0 = u.pn * 256 + wc * 32 + 8 * fq;
        u32x2 ac[2], bc[2], an[2], bn[2];
#pragma unroll
        for (int bj = 0; bj < 2; ++bj) { const unsigned char* p = gates + (size_t)ROW_OF(0, 0) * (2 * D) + col0 + bj * 128; ac[bj] = *(const u32x2*)p; bc[bj] = *(const u32x2*)(p + D); }
#pragma unroll
        for (int g = 0; g < 8; ++g) {
            const int ai = g >> 2, m = g & 3;
            if (g < 7) {
#pragma unroll
                for (int bj = 0; bj < 2; ++bj) { const unsigned char* p = gates + (size_t)ROW_OF((g + 1) >> 2, (g + 1) & 3) * (2 * D) + col0 + bj * 128; an[bj] = *(const u32x2*)p; bn[bj] = *(const u32x2*)(p + D); }
            }
#pragma unroll
            for (int bj = 0; bj < 2; ++bj) {
                const unsigned a0 = ac[bj].x, a1 = ac[bj].y, b0 = bc[bj].x, b1 = bc[bj].y;
                f32x4 r0, r1;
#pragma unroll
                for (int j = 0; j < 4; ++j) {
                    r0[j] = (float)((a0 >> (8 * j)) & 0xff) * __builtin_amdgcn_rcpf(fmaxf((float)((b0 >> (8 * j)) & 0xff), 0.5f));
                    r1[j] = (float)((a1 >> (8 * j)) & 0xff) * __builtin_amdgcn_rcpf(fmaxf((float)((b1 >> (8 * j)) & 0xff), 0.5f));
                }
                acc[ai][bj][m][0] = acc[ai][bj][m][0] * r0; acc[ai][bj][m][1] = acc[ai][bj][m][1] * r1;
            }
            if (g < 7) { ac[0] = an[0]; ac[1] = an[1]; bc[0] = bn[0]; bc[1] = bn[1]; }
        }
    }
    __device__ __forceinline__ void operator()(EPI_ARGS) const {
        const int col0 = u.pn * 256 + wc * 32 + 8 * fq;
        u32x2 gc[2], gn[2];
#pragma unroll
        for (int bj = 0; bj < 2; ++bj) gc[bj] = *(const u32x2*)(gates + (size_t)ROW_OF(0, 0) * (2 * D) + D + col0 + bj * 128);
#pragma unroll
        for (int g = 0; g < 8; ++g) {
            const int ai = g >> 2, m = g & 3, row = ROW_OF(ai, m);
            if (g < 7) {
#pragma unroll
                for (int bj = 0; bj < 2; ++bj) gn[bj] = *(const u32x2*)(gates + (size_t)ROW_OF((g + 1) >> 2, (g + 1) & 3) * (2 * D) + D + col0 + bj * 128);
            }
#pragma unroll
            for (int bj = 0; bj < 2; ++bj) {
                const unsigned b0 = gc[bj].x, b1 = gc[bj].y;
                f32x4 g0, g1;
#pragma unroll
                for (int j = 0; j < 4; ++j) { g0[j] = fmaxf((float)((b0 >> (8 * j)) & 0xff), 0.5f) * (1.0f / 255.0f); g1[j] = fmaxf((float)((b1 >> (8 * j)) & 0xff), 0.5f) * (1.0f / 255.0f); }
                const f32x4 v0 = acc[ai][bj][m][0] * g0, v1 = acc[ai][bj][m][1] * g1;
                u32x4 w; w.x = cvt_pk_bf16(v0[0], v0[1]); w.y = cvt_pk_bf16(v0[2], v0[3]); w.z = cvt_pk_bf16(v1[0], v1[1]); w.w = cvt_pk_bf16(v1[2], v1[3]);
                *(u32x4*)(merged + (size_t)row * D + col0 + bj * 128) = w;
            }
            if (g < 7) { gc[0] = gn[0]; gc[1] = gn[1]; }
        }
    }
};

struct EpiResid1 {
    static constexpr int MIDT = -1;
    const float* xin; bf16_t* xb; float* ss;
    __device__ __forceinline__ void operator()(EPI_ARGS) const {
        const int col0 = u.pn * 256 + wc * 32 + 8 * fq;
        f32x4 xc[2][2], xn[2][2];
#pragma unroll
        for (int bj = 0; bj < 2; ++bj) { const size_t off = (size_t)ROW_OF(0, 0) * D + col0 + bj * 128; xc[bj][0] = *(const f32x4*)(xin + off); xc[bj][1] = *(const f32x4*)(xin + off + 4); }
#pragma unroll
        for (int g = 0; g < 8; ++g) {
            const int ai = g >> 2, m = g & 3, row = ROW_OF(ai, m); float s = 0.f;
            if (g < 7) {
#pragma unroll
                for (int bj = 0; bj < 2; ++bj) { const size_t off = (size_t)ROW_OF((g + 1) >> 2, (g + 1) & 3) * D + col0 + bj * 128; xn[bj][0] = *(const f32x4*)(xin + off); xn[bj][1] = *(const f32x4*)(xin + off + 4); }
            }
#pragma unroll
            for (int bj = 0; bj < 2; ++bj) {
                const size_t off = (size_t)row * D + col0 + bj * 128;
                const f32x4 v0 = xc[bj][0] + acc[ai][bj][m][0], v1 = xc[bj][1] + acc[ai][bj][m][1];
                s += (v0[0] * v0[0] + v0[1] * v0[1]) + (v0[2] * v0[2] + v0[3] * v0[3]) + (v1[0] * v1[0] + v1[1] * v1[1]) + (v1[2] * v1[2] + v1[3] * v1[3]);
                u32x4 w; w.x = cvt_pk_bf16(v0[0], v0[1]); w.y = cvt_pk_bf16(v0[2], v0[3]); w.z = cvt_pk_bf16(v1[0], v1[1]); w.w = cvt_pk_bf16(v1[2], v1[3]); *(u32x4*)(xb + off) = w;
            }
            s += __shfl_xor(s, 16); s += __shfl_xor(s, 32);
            if (fq == 0) __hip_atomic_fetch_add(ss + row, s, __ATOMIC_RELAXED, __HIP_MEMORY_SCOPE_AGENT);
            if (g < 7) {
#pragma unroll
                for (int bj = 0; bj < 2; ++bj) { xc[bj][0] = xn[bj][0]; xc[bj][1] = xn[bj][1]; }
            }
        }
    }
};
struct EpiResid2 {
    static constexpr int MIDT = -1;
    bf16_t* xb; float* ss;
    __device__ __forceinline__ void operator()(EPI_ARGS) const {
        const int col0 = u.pn * 256 + wc * 32 + 8 * fq;
        u32x4 xc[2], xn[2];
#pragma unroll
        for (int bj = 0; bj < 2; ++bj) xc[bj] = *(const u32x4*)(xb + (size_t)ROW_OF(0, 0) * D + col0 + bj * 128);
#pragma unroll
        for (int g = 0; g < 8; ++g) {
            const int ai = g >> 2, m = g & 3, row = ROW_OF(ai, m); float s = 0.f;
            if (g < 7) {
#pragma unroll
                for (int bj = 0; bj < 2; ++bj) xn[bj] = *(const u32x4*)(xb + (size_t)ROW_OF((g + 1) >> 2, (g + 1) & 3) * D + col0 + bj * 128);
            }
#pragma unroll
            for (int bj = 0; bj < 2; ++bj) {
                UNPK4(xc[bj], x0, x1);
                const f32x4 v0 = x0 + acc[ai][bj][m][0], v1 = x1 + acc[ai][bj][m][1];
                s += (v0[0] * v0[0] + v0[1] * v0[1]) + (v0[2] * v0[2] + v0[3] * v0[3]) + (v1[0] * v1[0] + v1[1] * v1[1]) + (v1[2] * v1[2] + v1[3] * v1[3]);
                u32x4 w; w.x = cvt_pk_bf16(v0[0], v0[1]); w.y = cvt_pk_bf16(v0[2], v0[3]); w.z = cvt_pk_bf16(v1[0], v1[1]); w.w = cvt_pk_bf16(v1[2], v1[3]);
                *(u32x4*)(xb + (size_t)row * D + col0 + bj * 128) = w;
            }
            s += __shfl_xor(s, 16); s += __shfl_xor(s, 32);
            if (fq == 0) __hip_atomic_fetch_add(ss + row, s, __ATOMIC_RELAXED, __HIP_MEMORY_SCOPE_AGENT);
            if (g < 7) { xc[0] = xn[0]; xc[1] = xn[1]; }
        }
    }
};

struct EpiFinal {
    static constexpr int MIDT = -1;
    const bf16_t* xb; float* ss; unsigned* cnt; const float* gfin; float* out;
    __device__ __forceinline__ void operator()(f32x4 (&acc)[2][2][4][2], const Unit& u, int wr, int wc, int fr, int fq) const {
        const int col0 = u.pn * 256 + wc * 32 + 8 * fq;
        u32x4 xc[2], xn[2];
#pragma unroll
        for (int bj = 0; bj < 2; ++bj) xc[bj] = *(const u32x4*)(xb + (size_t)ROW_OF(0, 0) * D + col0 + bj * 128);
#pragma unroll
        for (int g = 0; g < 8; ++g) {
            const int ai = g >> 2, m = g & 3, row = ROW_OF(ai, m); float s = 0.f;
            if (g < 7) {
#pragma unroll
                for (int bj = 0; bj < 2; ++bj) xn[bj] = *(const u32x4*)(xb + (size_t)ROW_OF((g + 1) >> 2, (g + 1) & 3) * D + col0 + bj * 128);
            }
#pragma unroll
            for (int bj = 0; bj < 2; ++bj) {
                UNPK4(xc[bj], x0, x1);
                const f32x4 v0 = x0 + acc[ai][bj][m][0], v1 = x1 + acc[ai][bj][m][1];
                acc[ai][bj][m][0] = v0; acc[ai][bj][m][1] = v1;
                s += (v0[0] * v0[0] + v0[1] * v0[1]) + (v0[2] * v0[2] + v0[3] * v0[3]) + (v1[0] * v1[0] + v1[1] * v1[1]) + (v1[2] * v1[2] + v1[3] * v1[3]);
            }
            s += __shfl_xor(s, 16); s += __shfl_xor(s, 32);
            if (fq == 0) __hip_atomic_fetch_add(ss + row, s, __ATOMIC_RELAXED, __HIP_MEMORY_SCOPE_AGENT);
            if (g < 7) { xc[0] = xn[0]; xc[1] = xn[1]; }
        }
        asm volatile("s_waitcnt vmcnt(0)" ::: "memory"); __builtin_amdgcn_s_barrier();
        if (threadIdx.x == 0) {
            __hip_atomic_fetch_add(cnt + u.pm, 1u, __ATOMIC_RELAXED, __HIP_MEMORY_SCOPE_AGENT);
            unsigned sp = 0;
            while (__hip_atomic_load(cnt + u.pm, __ATOMIC_RELAXED, __HIP_MEMORY_SCOPE_AGENT) < 8u) { __builtin_amdgcn_s_sleep(1); if (++sp > (1u << 22)) break; }
        }
        asm volatile("s_waitcnt vmcnt(0) lgkmcnt(0)" ::: "memory"); __builtin_amdgcn_s_barrier(); asm volatile("" ::: "memory");
        float rs[8];
#pragma unroll
        for (int g = 0; g < 8; ++g) rs[g] = __hip_atomic_load(ss + ROW_OF(g >> 2, g & 3), __ATOMIC_RELAXED, __HIP_MEMORY_SCOPE_AGENT);
        f32x4 gf[2][2];
#pragma unroll
        for (int bj = 0; bj < 2; ++bj) { gf[bj][0] = *(const f32x4*)(gfin + col0 + bj * 128); gf[bj][1] = *(const f32x4*)(gfin + col0 + bj * 128 + 4); }
#pragma unroll
        for (int g = 0; g < 8; ++g) {
            const int ai = g >> 2, m = g & 3, row = ROW_OF(ai, m);
            const float r = 1.0f / sqrtf(rs[g] * (1.0f / D) + EPS);
#pragma unroll
            for (int bj = 0; bj < 2; ++bj) {
                float* op = out + (size_t)row * D + col0 + bj * 128;
                *(f32x4*)(op) = acc[ai][bj][m][0] * r * gf[bj][0]; *(f32x4*)(op + 4) = acc[ai][bj][m][1] * r * gf[bj][1];
            }
        }
    }
};

struct EpiUp {
    static constexpr int MIDT = -1;
    const float* ss2; const float* cw; const float* cb; bf16_t* act; float* tailg; float* headg; float* headv;
    __device__ __forceinline__ void operator()(EPI_ARGS) const {
        const int f0 = u.pn * 128 + wc * 32 + 8 * fq;
        const int lane = fq * 16 + fr, src1 = (lane & 48) | ((fr - 1) & 15), src2 = (lane & 48) | ((fr - 2) & 15);
        f32x4 w0[2], w1[2], w2[2], bb[2];
#pragma unroll
        for (int n = 0; n < 2; ++n) { w0[n] = *(const f32x4*)(cw + f0 + 4 * n); w1[n] = *(const f32x4*)(cw + FF + f0 + 4 * n); w2[n] = *(const f32x4*)(cw + 2 * FF + f0 + 4 * n); bb[n] = *(const f32x4*)(cb + f0 + 4 * n); }
        float rsv[2][4];
#pragma unroll
        for (int ai = 0; ai < 2; ++ai)
#pragma unroll
            for (int m = 0; m < 4; ++m) rsv[ai][m] = ss2[ROW_OF(ai, m)];
#pragma unroll
        for (int ai = 0; ai < 2; ++ai) {
            const int blk = u.pm * 4 + ai * 2 + wr;
            f32x4 q1[2], q2[2];
#pragma unroll
            for (int n = 0; n < 2; ++n) { q1[n] = (f32x4){0.f, 0.f, 0.f, 0.f}; q2[n] = (f32x4){0.f, 0.f, 0.f, 0.f}; }
#pragma unroll
            for (int m = 0; m < 4; ++m) {
                const int row = ROW_OF(ai, m);
                const float rs = __builtin_amdgcn_rsqf(rsv[ai][m] * (1.0f / D) + EPS);
                f32x4 o[2];
#pragma unroll
                for (int n = 0; n < 2; ++n) {
                    const f32x4 gv = acc[ai][0][m][n] * rs, vv = acc[ai][1][m][n] * rs;
                    f32x4 r1, r2;
#pragma unroll
                    for (int j = 0; j < 4; ++j) { r1[j] = __shfl(gv[j], src1); r2[j] = __shfl(gv[j], src2); }
                    f32x4 p1, p2;
#pragma unroll
                    for (int j = 0; j < 4; ++j) { p1[j] = fr >= 1 ? r1[j] : q1[n][j]; p2[j] = fr >= 2 ? r2[j] : q2[n][j]; }
                    q1[n] = r1; q2[n] = r2;
                    const f32x4 cv = bb[n] + w0[n] * p2 + w1[n] * p1 + w2[n] * gv;
                    o[n] = gelu4(cv) * vv;
                    if (m == 0 && fr < 2) { const size_t so = ((size_t)blk * 2 + fr) * FF + f0 + 4 * n; *(f32x4*)(headg + so) = gv; *(f32x4*)(headv + so) = vv; }
                    if (m == 3 && fr >= 14) { const size_t so = ((size_t)blk * 2 + (fr - 14)) * FF + f0 + 4 * n; *(f32x4*)(tailg + so) = gv; }
                }
                if (!(m == 0 && fr < 2)) {
                    u32x4 w; w.x = cvt_pk_bf16(o[0][0], o[0][1]); w.y = cvt_pk_bf16(o[0][2], o[0][3]); w.z = cvt_pk_bf16(o[1][0], o[1][1]); w.w = cvt_pk_bf16(o[1][2], o[1][3]);
                    __builtin_nontemporal_store(w, (u32x4*)(act + (size_t)row * FF + f0));
                }
            }
        }
    }
};

__device__ __forceinline__ void tr_tile(const float* src, int ldw, const float* ksc, bf16_t* dst, int ldd, LAS float* scr, int lane) {
    float v[32];
#pragma unroll
    for (int i = 0; i < 32; ++i) v[i] = src[(size_t)(2 * i + (lane >> 5)) * ldw + (lane & 31)];
#pragma unroll
    for (int i = 0; i < 32; ++i) scr[(2 * i + (lane >> 5)) * 33 + (lane & 31)] = v[i];
    LDS_WAIT();
    const int c = lane & 7;
    f32x4 k0 = (f32x4){1.f, 1.f, 1.f, 1.f}, k1 = k0;
    if (ksc) { k0 = *(const f32x4*)(ksc + 8 * c); k1 = *(const f32x4*)(ksc + 8 * c + 4); }
#pragma unroll
    for (int j = 0; j < 4; ++j) { const int n = (lane >> 3) + 8 * j; const LAS float* s = scr + (8 * c) * 33 + n;
        u32x4 o; o.x = cvt_pk_bf16(s[0 * 33] * k0[0], s[1 * 33] * k0[1]); o.y = cvt_pk_bf16(s[2 * 33] * k0[2], s[3 * 33] * k0[3]);
        o.z = cvt_pk_bf16(s[4 * 33] * k1[0], s[5 * 33] * k1[1]); o.w = cvt_pk_bf16(s[6 * 33] * k1[2], s[7 * 33] * k1[3]);
        *(u32x4*)(dst + (size_t)n * ldd + 8 * c) = o; }
    LDS_WAIT();
}
__device__ __forceinline__ void tr_plain(const float* W, int K, int N, const float* ksc, bf16_t* WT, int item, LAS float* scr, int lane) {
    const int nblk = N / 32, kb = item / nblk, nb = item % nblk, k0 = kb * 64, n0 = nb * 32;
    tr_tile(W + (size_t)k0 * N + n0, N, ksc ? ksc + k0 : nullptr, WT + (size_t)n0 * K + k0, K, scr, lane);
}


#define UNPK8(q, f) const float f[8] = {bf_lo((q).x), bf_hi((q).x), bf_lo((q).y), bf_hi((q).y), bf_lo((q).z), bf_hi((q).z), bf_lo((q).w), bf_hi((q).w)}
template <int W> __device__ __forceinline__ void pool_run(const bf16_t* up, bf16_t* dp, int t0) {
    u32x4 q[W + 15];
#pragma unroll
    for (int i = 0; i < W + 15; ++i) { const int dt = i - (W - 1); const bool ok = (t0 + dt >= 0); const u32x4 v = *(const u32x4*)(up + (ptrdiff_t)(ok ? dt : 0) * PW); q[i] = ok ? v : (u32x4){0u, 0u, 0u, 0u}; }
    float s[8];
#pragma unroll
    for (int e = 0; e < 8; ++e) s[e] = 0.f;
#pragma unroll
    for (int i = 0; i < W - 1; ++i) { UNPK8(q[i], f);
#pragma unroll
        for (int e = 0; e < 8; ++e) s[e] += f[e]; }
#pragma unroll
    for (int j = 0; j < 16; ++j) {
        UNPK8(q[j + W - 1], cur);
#pragma unroll
        for (int e = 0; e < 8; ++e) s[e] += cur[e];
        const int cnt = (t0 + j + 1) < W ? (t0 + j + 1) : W; const float inv = 1.0f / (float)cnt;
        u32x4 o; o.x = cvt_pk_bf16(s[0] * inv - cur[0], s[1] * inv - cur[1]); o.y = cvt_pk_bf16(s[2] * inv - cur[2], s[3] * inv - cur[3]);
        o.z = cvt_pk_bf16(s[4] * inv - cur[4], s[5] * inv - cur[5]); o.w = cvt_pk_bf16(s[6] * inv - cur[6], s[7] * inv - cur[7]);
        *(u32x4*)(dp + (size_t)j * PW) = o;
        UNPK8(q[j], old);
#pragma unroll
        for (int e = 0; e < 8; ++e) s[e] -= old[e];
    }
}

struct Args { const float* in[22]; float* out; unsigned char* ws; };
#ifndef PH_MASK
#define PH_MASK 0xFFFF
#endif
#define PH(k) if constexpr ((PH_MASK >> (k)) & 1)
#ifndef REP_MASK
#define REP_MASK 0
#endif
#define REPS(k) for (int rep_ = 0; rep_ < 1 + ((REP_MASK >> (k)) & 1); ++rep_)

__global__ void __launch_bounds__(NTHR, 2) hybrid_block_fwd(Args a) {
    extern __shared__ __attribute__((aligned(16))) unsigned char lds_raw[];
    LAS unsigned char* lds = (LAS unsigned char*)lds_raw;
    cg::grid_group grid = cg::this_grid();
#define IDS() int tid = threadIdx.x; asm volatile("" : "+v"(tid)); const int lane = tid & 63, wave = __builtin_amdgcn_readfirstlane(tid >> 6); const int gtid = blockIdx.x * NTHR + tid, gw = blockIdx.x * (NTHR / 64) + wave; LAS float* scr = (LAS float*)(lds + wave * 16384); (void)lane; (void)gtid; (void)gw; (void)scr;
    unsigned char* ws = a.ws;
    volatile LAS unsigned* MISC = (volatile LAS unsigned*)(lds + 131072);
    if (threadIdx.x < 64) MISC[threadIdx.x] = 0u;
    unsigned* BARW = (unsigned*)(ws + WS_BAR);
    unsigned* PCNT = (unsigned*)(ws + WS_CNT);
    __syncthreads();
    if (ws == nullptr) grid.sync();
    const XcdBarrier xbar = xcd_barrier_post(BARW, MISC + 8);
    const float* x = a.in[0]; const float* g_mix = a.in[1]; const float* w_in = a.in[2]; const float* b_gate = a.in[3];
    const float* w_pool = a.in[4]; const float* pool_scale = a.in[5]; const float* lru_conv_w = a.in[6]; const float* lru_conv_b = a.in[7];
    const float* w_a = a.in[8]; const float* b_a = a.in[9]; const float* w_i = a.in[10]; const float* b_i = a.in[11]; const float* lru_lambda = a.in[12];
    const float* w_pool_proj = a.in[13]; const float* w_lru_proj = a.in[14]; const float* w_out = a.in[15]; const float* g_mlp = a.in[16];
    const float* w_up = a.in[17]; const float* ffn_conv_w = a.in[18]; const float* ffn_conv_b = a.in[19]; const float* w_down = a.in[20]; const float* g_final = a.in[21];
    float* out = a.out;
    float* RSTD1 = (float*)(ws + WS_RSTD1); float* SS2 = (float*)(ws + WS_SS2); float* SS3 = (float*)(ws + WS_SS3); float* SP8 = (float*)(ws + WS_SP8);
    float* AGGP = (float*)(ws + WS_AGGP); float* AGGH = (float*)(ws + WS_AGGH);
    bf16_t* WT_POOL = (bf16_t*)(ws + WS_WT_POOL); bf16_t* WT_GATE = (bf16_t*)(ws + WS_WT_GATE); bf16_t* WT_CAT = (bf16_t*)(ws + WS_WT_PP);
    bf16_t* WT_OUT = (bf16_t*)(ws + WS_WT_OUT); bf16_t* WT_IN = (bf16_t*)(ws + WS_WT_IN);
    bf16_t* WT_UP = (bf16_t*)(ws + WS_WT_UP); bf16_t* WT_DOWN = (bf16_t*)(ws + WS_WT_DOWN);
    bf16_t* XB = (bf16_t*)(ws + WS_XB); bf16_t* DD = (bf16_t*)(ws + WS_DD); bf16_t* VV = (bf16_t*)(ws + WS_V2); float* HEADU = (float*)(ws + WS_HEADU); float* TAILU = (float*)(ws + WS_TAILU); bf16_t* YCAT = (bf16_t*)(ws + WS_YCAT);
    bf16_t* UPOOL = (bf16_t*)(ws + WS_UPOOL); bf16_t* GELU_U = (bf16_t*)(ws + WS_GELU); bf16_t* X1B = (bf16_t*)(ws + WS_X1B);
    bf16_t* GATES = (bf16_t*)(ws + WS_GATES); bf16_t* ULRU = (bf16_t*)(ws + WS_ULRU); bf16_t* BX = (bf16_t*)(ws + WS_BX); bf16_t* MERGED = (bf16_t*)(ws + WS_MERGED);
    bf16_t* ACT = (bf16_t*)(ws + WS_ACT); float* TAILG = (float*)(ws + WS_TAILG); float* HEADG = (float*)(ws + WS_HEADG); float* HEADV = (float*)(ws + WS_HEADV);
    float* AF = out;

    PH(0) REPS(0) { IDS();
    for (int i = gtid; i < 2 * M; i += NT) SS2[i] = 0.f;
    for (int i = gtid; i < LW; i += NT) SP8[i] = 8.0f * log1pf(expf(-lru_lambda[i]));
    {
        constexpr int I_IN = (D / 64) * (INW / 32), I_PP = (PW / 64) * (D / 32), I_LP = (LW / 64) * (D / 32), I_OUT = (D / 64) * (D / 32), I_POOL = 4 * 4 * 8, I_GATE = 4 * 128;
        constexpr int NITEMS = I_IN + I_PP + I_LP + I_OUT + I_POOL + I_GATE;
        for (int it = gw; it < NITEMS; it += NWV) {
            int r = it;
            if (r < I_IN) { tr_plain(w_in, D, INW, g_mix, WT_IN, r, scr, lane); continue; } r -= I_IN;
            if (r < I_PP) { const int kb = r / (D / 32), nb = r % (D / 32); tr_tile(w_pool_proj + (size_t)kb * 64 * D + nb * 32, D, nullptr, WT_CAT + (size_t)nb * 32 * KC + kb * 64, KC, scr, lane); continue; } r -= I_PP;
            if (r < I_LP) { const int kb = r / (D / 32), nb = r % (D / 32); tr_tile(w_lru_proj + (size_t)kb * 64 * D + nb * 32, D, nullptr, WT_CAT + (size_t)nb * 32 * KC + PW + kb * 64, KC, scr, lane); continue; } r -= I_LP;
            if (r < I_OUT) { tr_plain(w_out, D, D, nullptr, WT_OUT, r, scr, lane); continue; } r -= I_OUT;
            if (r < I_POOL) { const int g = r >> 5; tr_plain(w_pool + (size_t)g * 65536, 256, 256, nullptr, WT_POOL + (size_t)g * 65536, r & 31, scr, lane); continue; } r -= I_POOL;
            {
                const int kb = r >> 7, nb = r & 127, n0 = nb * 32, pn = n0 >> 8, bj = (n0 >> 7) & 1, j0 = n0 & 127, k0 = kb * 64;
                const float* W = (bj ? w_i : w_a) + (size_t)(pn >> 1) * 65536;
                tr_tile(W + (size_t)k0 * 256 + (pn & 1) * 128 + j0, 256, nullptr, WT_GATE + (size_t)n0 * 256 + k0, 256, scr, lane);
            }
        }
        for (int row = gw; row < M; row += NWV) {
            const f32x4* xr = (const f32x4*)(x + (size_t)row * D) + lane; f32x4 v[8]; float s = 0.f;
#pragma unroll
            for (int j = 0; j < 8; ++j) { v[j] = xr[64 * j]; s += (v[j][0] * v[j][0] + v[j][1] * v[j][1]) + (v[j][2] * v[j][2] + v[j][3] * v[j][3]); }
            s = wave_sum(s);
            const float rs1 = 1.0f / sqrtf(s * (1.0f / D) + EPS);
            u32x2* o = (u32x2*)(XB + (size_t)row * D) + lane;
#pragma unroll
            for (int j = 0; j < 8; ++j) { u32x2 w; w.x = cvt_pk_bf16(v[j][0] * rs1, v[j][1] * rs1); w.y = cvt_pk_bf16(v[j][2] * rs1, v[j][3] * rs1); o[64 * j] = w; }
        }
    }
    }
    xcd_barrier(xbar);

    PH(1) REPS(1)
    {
        pg8::Gemm g{XB, WT_IN, D, D, 0}; pg8::Order2D S; S.init(M, INW, (int)blockIdx.x);
        EpiProj E{SS2, b_gate, UPOOL, ULRU, GELU_U, GATES, lru_conv_w, lru_conv_b, VV, HEADU, TAILU};
        pg8::gemm_phase(lds, g, S, E);
    }
    xcd_barrier(xbar);

    PH(2) REPS(2)
    { IDS();
        {
            const int grp = __builtin_amdgcn_readfirstlane(gtid >> 15), run = (gtid >> 5) & 1023, c = grp * 256 + (gtid & 31) * 8, r0 = run * 16, t0 = r0 & (SEQ - 1);
            const bf16_t* up = UPOOL + (size_t)r0 * PW + c; bf16_t* dp = DD + (size_t)r0 * PW + c;
            if (grp == 0) pool_run<2>(up, dp, t0); else if (grp == 1) pool_run<4>(up, dp, t0); else if (grp == 2) pool_run<8>(up, dp, t0); else pool_run<16>(up, dp, t0);
        }
        for (int idx = gtid; idx < 256 * 3 * (LW / 4); idx += NT) {
            const int c4 = (idx % (LW / 4)) * 4, rr = (idx / (LW / 4)) % 3, blk = idx / (3 * (LW / 4));
            const bool seq0 = (blk & 127) == 0; const int pb = seq0 ? blk : blk - 1; const size_t row = (size_t)blk * 64 + rr;
            const float* H = HEADU + (size_t)blk * 3 * LW + c4; const float* T = TAILU + (size_t)pb * 3 * LW + c4;
            const f32x4 z = (f32x4){0.f, 0.f, 0.f, 0.f};
            const f32x4 t0 = *(const f32x4*)(T), t1 = *(const f32x4*)(T + LW), t2 = *(const f32x4*)(T + 2 * LW);
            const f32x4 h0 = *(const f32x4*)(H), h1 = *(const f32x4*)(H + (rr >= 1 ? LW : 0)), h2 = *(const f32x4*)(H + (rr >= 2 ? 2 * LW : 0));
            const f32x4 T0 = seq0 ? z : t0, T1 = seq0 ? z : t1, T2 = seq0 ? z : t2;
            const f32x4 u0 = rr == 0 ? h0 : (rr == 1 ? h1 : h2);
            const f32x4 u1 = rr == 0 ? T2 : (rr == 1 ? h0 : h1);
            const f32x4 u2 = rr == 0 ? T1 : (rr == 1 ? T2 : h0);
            const f32x4 u3 = rr == 0 ? T0 : (rr == 1 ? T1 : T2);
            const f32x4 v = *(const f32x4*)(lru_conv_b + c4) + *(const f32x4*)(lru_conv_w + c4) * u3 + *(const f32x4*)(lru_conv_w + LW + c4) * u2 + *(const f32x4*)(lru_conv_w + 2 * LW + c4) * u1 + *(const f32x4*)(lru_conv_w + 3 * LW + c4) * u0;
            u32x2 w; w.x = cvt_pk_bf16(v[0], v[1]); w.y = cvt_pk_bf16(v[2], v[3]);
            *(u32x2*)(VV + row * LW + c4) = w;
        }
    }
    xcd_barrier(xbar);

    PH(3) REPS(3)
    {
        { pg8::Gemm g{DD, WT_POOL, PW, 256, 1}; pg8::StaticOrder S; S.init(M, PW, NWG, (int)blockIdx.x);
          EpiPool E{pool_scale, YCAT}; pg8::gemm_phase(lds, g, S, E); }
        { pg8::Gemm g{VV, WT_GATE, LW, 256, 2}; pg8::StaticOrder S; S.init(M, 2 * LW, NWG, (int)blockIdx.x);
          EpiLru E{VV, b_a, b_i, SP8, (unsigned*)AF}; pg8::gemm_phase(lds, g, S, E); }
    }
    xcd_barrier(xbar);

    PH(4) REPS(4)
    { IDS();
        const int c2 = gtid & 1023, chunk = (gtid >> 10) & (NCH - 1), b = gtid >> 16;
        const size_t r0 = (size_t)b * SEQ + (size_t)chunk * CH_L;
        const u32x2* pab = (const u32x2*)((const unsigned*)AF + r0 * LW) + c2;
        f32x2 P = (f32x2){1.f, 1.f}, H = (f32x2){0.f, 0.f};
#pragma unroll 32
        for (int i = 0; i < CH_L; ++i) { const u32x2 q = pab[(size_t)i * (LW / 2)];
            const f32x2 av = (f32x2){__builtin_amdgcn_exp2f(bf_lo(q.x)), __builtin_amdgcn_exp2f(bf_lo(q.y))}, bv = (f32x2){bf_hi(q.x), bf_hi(q.y)}; P = P * av; H = av * H + bv; }
        ((f32x2*)(AGGP + (size_t)(b * NCH + chunk) * LW))[c2] = P; ((f32x2*)(AGGH + (size_t)(b * NCH + chunk) * LW))[c2] = H;
    }
    xcd_barrier(xbar);

    PH(5) REPS(5)
    { IDS();
        const int c2 = gtid & 1023, chunk = (gtid >> 10) & (NCH - 1), b = gtid >> 16;
        f32x2 H = (f32x2){0.f, 0.f};
#pragma unroll 4
        for (int j = 0; j < chunk; ++j) { const f32x2 P = ((const f32x2*)(AGGP + (size_t)(b * NCH + j) * LW))[c2], Hj = ((const f32x2*)(AGGH + (size_t)(b * NCH + j) * LW))[c2]; H = P * H + Hj; }
        const size_t r0 = (size_t)b * SEQ + (size_t)chunk * CH_L;
        const u32x2* pab = (const u32x2*)((const unsigned*)AF + r0 * LW) + c2;
        const unsigned* pg = (const unsigned*)(GELU_U + r0 * LW) + c2; unsigned* po = (unsigned*)(YCAT + r0 * KC + PW) + c2;
#pragma unroll 16
        for (int i = 0; i < CH_L; ++i) {
            const u32x2 q = pab[(size_t)i * (LW / 2)]; const f32x2 av = (f32x2){__builtin_amdgcn_exp2f(bf_lo(q.x)), __builtin_amdgcn_exp2f(bf_lo(q.y))}, bv = (f32x2){bf_hi(q.x), bf_hi(q.y)}; const unsigned gq = pg[(size_t)i * (LW / 2)];
            H = av * H + bv;
            po[(size_t)i * (KC / 2)] = cvt_pk_bf16(H.x * bf_lo(gq), H.y * bf_hi(gq));
        }
    }
    xcd_barrier(xbar);

    PH(6) REPS(6)
    {
        pg8::StaticOrder S; S.init(M, D, NWG, (int)blockIdx.x);
        { pg8::Gemm g{YCAT, WT_CAT, KC, KC, 0}; EpiMerge E{(const unsigned char*)GATES, MERGED}; pg8::gemm_phase(lds, g, S, E); }
    }
    xcd_barrier(xbar);

    PH(7) REPS(7)
    { IDS();
        { pg8::Gemm g{MERGED, WT_OUT, D, D, 0}; pg8::StaticOrder S; S.init(M, D, NWG, (int)blockIdx.x);
          EpiResid1 E{x, X1B, SS2}; pg8::gemm_phase(lds, g, S, E); }
        constexpr int I_UP = (D / 64) * (2 * FF / 32), I_DOWN = (FF / 64) * (D / 32);
        for (int rep2_ = 0; rep2_ < 1 + ((REP_MASK >> 12) & 1); ++rep2_)
        for (int it = gw; it < I_UP + I_DOWN; it += NWV) {
            if (it < I_UP) {
                const int nblk = 2 * FF / 32, kb = it / nblk, nb = it % nblk, n0 = nb * 32, pn = n0 >> 8, bj = (n0 >> 7) & 1, j0 = n0 & 127, k0 = kb * 64;
                tr_tile(w_up + (size_t)k0 * (2 * FF) + bj * FF + pn * 128 + j0, 2 * FF, g_mlp + k0, WT_UP + (size_t)n0 * D + k0, D, scr, lane);
            } else tr_plain(w_down, FF, D, nullptr, WT_DOWN, it - I_UP, scr, lane);
        }
    }
    xcd_barrier(xbar);

    PH(8) REPS(8)
    {
        pg8::Gemm g{X1B, WT_UP, D, D, 0}; pg8::Order2D S; S.init(M, 2 * FF, (int)blockIdx.x);
        EpiUp E{SS2, ffn_conv_w, ffn_conv_b, ACT, TAILG, HEADG, HEADV}; pg8::gemm_phase(lds, g, S, E);
    }
    xcd_barrier(xbar);

    PH(9) REPS(9)
    { IDS();
        for (int idx = gtid; idx < 256 * 2 * (FF / 4); idx += NT) {
            const int f4 = (idx % (FF / 4)) * 4, rr = (idx / (FF / 4)) & 1, blk = idx / (2 * (FF / 4));
            const bool seq0 = (blk & 127) == 0; const size_t row = (size_t)blk * 64 + rr;
            const f32x4 z = (f32x4){0.f, 0.f, 0.f, 0.f};
            const f32x4 gc = *(const f32x4*)(HEADG + ((size_t)blk * 2 + rr) * FF + f4), vv = *(const f32x4*)(HEADV + ((size_t)blk * 2 + rr) * FF + f4);
            f32x4 p1, p2;
            if (rr == 0) { p1 = seq0 ? z : *(const f32x4*)(TAILG + ((size_t)(blk - 1) * 2 + 1) * FF + f4); p2 = seq0 ? z : *(const f32x4*)(TAILG + ((size_t)(blk - 1) * 2 + 0) * FF + f4); }
            else { p1 = *(const f32x4*)(HEADG + ((size_t)blk * 2 + 0) * FF + f4); p2 = seq0 ? z : *(const f32x4*)(TAILG + ((size_t)(blk - 1) * 2 + 1) * FF + f4); }
            const f32x4 cv = *(const f32x4*)(ffn_conv_b + f4) + *(const f32x4*)(ffn_conv_w + f4) * p2 + *(const f32x4*)(ffn_conv_w + FF + f4) * p1 + *(const f32x4*)(ffn_conv_w + 2 * FF + f4) * gc;
            u32x2 w; w.x = cvt_pk_bf16(gelu_tanh(cv[0]) * vv[0], gelu_tanh(cv[1]) * vv[1]); w.y = cvt_pk_bf16(gelu_tanh(cv[2]) * vv[2], gelu_tanh(cv[3]) * vv[3]);
            *(u32x2*)(ACT + row * FF + f4) = w;
        }
    }
    xcd_barrier(xbar);

    PH(10) REPS(10)
    {
        pg8::Gemm g{ACT, WT_DOWN, FF, FF, 0}; pg8::PanelOrder S{(int)blockIdx.x};
        EpiFinal E{X1B, SS3, PCNT, g_final, out}; pg8::gemm_phase(lds, g, S, E);
    }
}

extern "C" void kernel_launch(void* const* d_in, const int* in_sizes, int n_in, void* d_out, int out_size, void* d_ws, size_t ws_size, hipStream_t stream) {
    static int grid = 0;
    if (grid == 0) {
        if (n_in != 22 || in_sizes[0] != M * D || out_size != M * D || ws_size < WS_END) {
            fprintf(stderr, "kernel_launch: unexpected shapes: n_in %d in0 %d out %d ws %zu (need >= %zu)\n", n_in, n_in > 0 ? in_sizes[0] : -1, out_size, ws_size, (size_t)WS_END); grid = -1; return; }
        int dev = 0, cus = 0, per_cu = 0;
        hipGetDevice(&dev); hipDeviceGetAttribute(&cus, hipDeviceAttributeMultiprocessorCount, dev);
        if (hipFuncSetAttribute((const void*)hybrid_block_fwd, hipFuncAttributeMaxDynamicSharedMemorySize, LDS_BYTES) != hipSuccess) { fprintf(stderr, "kernel_launch: hipFuncSetAttribute failed\n"); grid = -1; return; }
        hipOccupancyMaxActiveBlocksPerMultiprocessor(&per_cu, (const void*)hybrid_block_fwd, NTHR, LDS_BYTES);
        (void)hipGetLastError();
        if (cus != NWG || per_cu < 1) fprintf(stderr, "kernel_launch: note: cus %d per_cu %d (kernel is built for a 256-workgroup grid)\n", cus, per_cu);
        grid = NWG;
    }
    if (grid < 0) return;
    if (hipMemsetAsync((char*)d_ws + WS_BAR, 0, (WS_CNT - WS_BAR) + 256, stream) != hipSuccess) { fprintf(stderr, "kernel_launch: hipMemsetAsync failed\n"); return; }
    Args a{};
    for (int i = 0; i < 22; ++i) a.in[i] = (const float*)d_in[i];
    a.out = (float*)d_out; a.ws = (unsigned char*)d_ws;
    void* args[] = {&a};
    hipError_t e = hipLaunchCooperativeKernel((const void*)hybrid_block_fwd, dim3(grid), dim3(NTHR), args, LDS_BYTES, stream);
    if (e != hipSuccess) fprintf(stderr, "kernel_launch: cooperative launch failed: %s\n", hipGetErrorString(e));
}
```

```cpp
#include <hip/hip_runtime.h>
#include <hip/hip_cooperative_groups.h>
#include <cstdio>
#include <cstdint>
namespace cg = cooperative_groups;

#define LAS __attribute__((address_space(3)))
typedef unsigned short bf16_t;
typedef short bf16x8 __attribute__((ext_vector_type(8)));
typedef float f32x4 __attribute__((ext_vector_type(4)));
typedef float f32x2 __attribute__((ext_vector_type(2)));
typedef unsigned u32x4 __attribute__((ext_vector_type(4)));
typedef unsigned u32x2 __attribute__((ext_vector_type(2)));

constexpr int M = 16384, SEQ = 8192, D = 2048, PW = 1024, LW = 2048, INW = 9216, FF = 6144, KC = PW + LW;
constexpr float EPS = 1e-6f;
constexpr int NWG = 256, NTHR = 512, NT = NWG * NTHR, NWV = NT / 64;
constexpr int CH_L = 128, NCH = SEQ / CH_L;

constexpr size_t MiB = 1u << 20;
constexpr size_t WS_RSTD1 = 0, WS_SS2 = 64 * 1024, WS_SS3 = 128 * 1024, WS_SP8 = 192 * 1024;
constexpr size_t WS_BAR = 256 * 1024;
constexpr size_t WS_CNT = 320 * 1024;
constexpr size_t WS_AGGP = 1 * MiB, WS_AGGH = 2 * MiB;
constexpr size_t WS_WT_POOL = 4 * MiB;
constexpr size_t WS_WT_GATE = WS_WT_POOL + MiB / 2;
constexpr size_t WS_WT_PP = WS_WT_GATE + 2 * MiB;
constexpr size_t WS_WT_LP = WS_WT_PP + 4 * MiB;
constexpr size_t WS_WT_OUT = WS_WT_LP + 8 * MiB;
constexpr size_t WS_XB = 27 * MiB;
constexpr size_t WS_WT_IN = 91 * MiB;
constexpr size_t WS_DD = 27 * MiB;
constexpr size_t WS_V = 59 * MiB;
constexpr size_t WS_YLRU = 59 * MiB;
constexpr size_t WS_UPOOL = 127 * MiB;
constexpr size_t WS_YPOOL = 127 * MiB;
constexpr size_t WS_GELU = 159 * MiB;
constexpr size_t WS_X1B = 159 * MiB;
constexpr size_t WS_GATES = 223 * MiB;
constexpr size_t WS_WT_UP = 223 * MiB;
constexpr size_t WS_WT_DOWN = 271 * MiB;
constexpr size_t WS_ULRU = 351 * MiB;
constexpr size_t WS_BX = 351 * MiB;
constexpr size_t WS_V2 = 287 * MiB;
constexpr size_t WS_HEADU = 447 * MiB, WS_TAILU = 453 * MiB;
constexpr size_t WS_YCAT = 351 * MiB;
constexpr size_t WS_MERGED = 447 * MiB;
constexpr size_t WS_ACT = 295 * MiB;
constexpr size_t WS_TAILG = 27 * MiB, WS_HEADG = 39 * MiB, WS_HEADV = 51 * MiB;
constexpr size_t WS_END = 511 * MiB;

constexpr int LDS_BYTES = 131072 + 4096;

__device__ __forceinline__ unsigned cvt_pk_bf16(float lo, float hi) { unsigned r; asm volatile("v_cvt_pk_bf16_f32 %0, %1, %2" : "=v"(r) : "v"(lo), "v"(hi)); return r; }
__device__ __forceinline__ float bf_lo(unsigned w) { return __uint_as_float(w << 16); }
__device__ __forceinline__ float bf_hi(unsigned w) { return __uint_as_float(w & 0xffff0000u); }
__device__ __forceinline__ float sigmoidf_(float x) { return __builtin_amdgcn_rcpf(1.0f + __builtin_amdgcn_exp2f(-1.4426950409f * x)); }
__device__ __forceinline__ float gelu_tanh(float x) {
    const float u = x * (1.5957691216f + 0.0713548163f * x * x);
    return x * __builtin_amdgcn_rcpf(1.0f + __builtin_amdgcn_exp2f(-1.4426950409f * u));
}
__device__ __forceinline__ f32x4 gelu4(f32x4 x) {
    const f32x4 u = x * (x * x * (-0.10294324f) + (-2.3022082f));
    f32x4 e;
#pragma unroll
    for (int j = 0; j < 4; ++j) e[j] = __builtin_amdgcn_exp2f(u[j]);
    const f32x4 d = e + 1.0f; f32x4 r;
#pragma unroll
    for (int j = 0; j < 4; ++j) r[j] = __builtin_amdgcn_rcpf(d[j]);
    return x * r;
}
__device__ __forceinline__ f32x4 sigmoid4(f32x4 x) {
    const f32x4 u = x * (-1.4426950409f); f32x4 e;
#pragma unroll
    for (int j = 0; j < 4; ++j) e[j] = __builtin_amdgcn_exp2f(u[j]);
    const f32x4 d = e + 1.0f; f32x4 r;
#pragma unroll
    for (int j = 0; j < 4; ++j) r[j] = __builtin_amdgcn_rcpf(d[j]);
    return r;
}
__device__ __forceinline__ float wave_sum(float v) {
#pragma unroll
    for (int o = 1; o < 64; o <<= 1) v += __shfl_xor(v, o);
    return v;
}
#define LDS_WAIT() asm volatile("s_waitcnt lgkmcnt(0)" ::: "memory")


#define XB_TMO      128
#define XB_XCNT(j)  (256  + 64 * (j))
#define XB_XSUB(j)  (1280 + 64 * (j))
#define XB_XGEN(j)  (2304 + 64 * (j))
#define XB_TOP      3328
#define XB_TOPGEN   3392
#define XCD_BAR_WORDS 3456
#define XB_SPIN_CAP (1u << 20)
__device__ __forceinline__ unsigned xb_ld(unsigned* p)              { return __hip_atomic_load(p, __ATOMIC_RELAXED, __HIP_MEMORY_SCOPE_AGENT); }
__device__ __forceinline__ unsigned xb_add(unsigned* p, unsigned v) { return __hip_atomic_fetch_add(p, v, __ATOMIC_RELAXED, __HIP_MEMORY_SCOPE_AGENT); }
__device__ __forceinline__ unsigned xb_xcc_id() { return (unsigned)__builtin_amdgcn_s_getreg((3 << 11) | 20) & 0xFu; }
#define XB_SPIN(cond, bar) do { unsigned _sp = 0; while (cond) { __builtin_amdgcn_s_sleep(1); \
    if ((++_sp & 255u) == 0u) { if (xb_ld(&(bar)[XB_TMO])) break; if (_sp > XB_SPIN_CAP) { atomicAdd(&(bar)[XB_TMO], 1u); break; } } } } while (0)
struct XcdBarrier { unsigned* bar; unsigned x; volatile LAS unsigned* st; };
__device__ __forceinline__ XcdBarrier xcd_barrier_post(unsigned* bar, volatile LAS unsigned* st) {
    XcdBarrier b; b.bar = bar; b.x = xb_xcc_id(); b.st = st;
    if (threadIdx.x == 0) (void)xb_add(&bar[XB_XCNT(b.x)], 1u);
    return b;
}
__device__ __forceinline__ void xcd_barrier_complete(unsigned* bar, unsigned x, unsigned& nloc, unsigned& nx) {
    const unsigned G = gridDim.x * gridDim.y * gridDim.z;
    unsigned sum, cnt, mine, sp = 0u;
    for (;;) {
        sum = 0u; cnt = 0u; mine = 0u;
#pragma unroll
        for (unsigned j = 0; j < 16; ++j) { const unsigned c = xb_ld(&bar[XB_XCNT(j)]); sum += c; cnt += (c > 0u) ? 1u : 0u; mine = (j == x) ? c : mine; }
        if (sum == G) break;
        __builtin_amdgcn_s_sleep(1);
        if ((++sp & 255u) == 0u) { if (xb_ld(&bar[XB_TMO])) break; if (sp > XB_SPIN_CAP) { atomicAdd(&bar[XB_TMO], 1u); break; } }
    }
    nloc = mine > 0u ? mine : 1u; nx = cnt > 0u ? cnt : 1u;
}
__device__ __forceinline__ void xcd_barrier(const XcdBarrier& b) {
    asm volatile("s_waitcnt vmcnt(0)" ::: "memory");
    __syncthreads();
    if (threadIdx.x == 0) {
        unsigned* bar = b.bar;
        __builtin_amdgcn_s_waitcnt(0);
        unsigned nloc = b.st[0], nx = b.st[1];
        if (nloc == 0u) { xcd_barrier_complete(bar, b.x, nloc, nx); b.st[0] = nloc; b.st[1] = nx; }
        const unsigned old = xb_add(&bar[XB_XSUB(b.x)], 1u);
        const unsigned gen = old / nloc;
        if (old + 1u == (gen + 1u) * nloc) {
            __builtin_amdgcn_fence(__ATOMIC_RELEASE, "agent");
            asm volatile("s_waitcnt vmcnt(0)" ::: "memory");
            const unsigned og = xb_add(&bar[XB_TOP], 1u);
            const unsigned tg = og / nx;
            if (og + 1u == (tg + 1u) * nx) xb_add(&bar[XB_TOPGEN], 1u);
            else XB_SPIN(xb_ld(&bar[XB_TOPGEN]) == tg, bar);
            __builtin_amdgcn_fence(__ATOMIC_ACQUIRE, "agent");
            xb_add(&bar[XB_XGEN(b.x)], 1u);
            asm volatile("s_waitcnt vmcnt(0)" ::: "memory");
        } else {
            XB_SPIN(xb_ld(&bar[XB_XGEN(b.x)]) == gen, bar);
            __builtin_amdgcn_fence(__ATOMIC_ACQUIRE, "agent");
            asm volatile("s_waitcnt vmcnt(0)" ::: "memory");
        }
    }
    __syncthreads();
}

namespace pg8 {
constexpr int BM = 256, BK = 64, HALF = 128, HTB = HALF * BK * 2, STAGE_BYTES = 8 * HTB, NXCD = 8, WGM = 2;
__host__ __device__ __forceinline__ int lds_byte(int r, int c) { const int st = (r >> 4) * 2 + (c >> 5), rr = r & 15, cc = c & 31, ob = rr * 64 + cc * 2; return st * 1024 + (ob ^ (((ob >> 9) & 1) << 5)); }
__host__ __device__ __forceinline__ void stage_rc(int b, int& R, int& C) { const int st = b / 1024, sb = b % 1024, swz = sb ^ (((sb >> 9) & 1) << 5); R = (st >> 1) * 16 + swz / 64; C = (st & 1) * 32 + (swz % 64) / 2; }
__host__ __device__ __forceinline__ int perm32(int rho) { const int n = rho >> 4, i = rho & 15; return 8 * (i >> 2) + 4 * n + (i & 3); }

struct Unit { int pm, pn; };
struct Gemm { const bf16_t* A; const bf16_t* Bt; int lda, K, agrp; };

struct StaticOrder {
    int nM, nN, nwg, G, c;
    __device__ void init(int M_, int N_, int G_, int c_) { nM = M_ / BM; nN = N_ / BM; nwg = nM * nN; G = G_; c = c_; }
    __device__ bool next(int i, Unit& u) const {
        const long L = (long)i * G + c; if (L >= nwg) return false;
        int wgid = (int)L; { const int q = nwg / NXCD, r = nwg % NXCD, xcd = wgid % NXCD, off = wgid / NXCD; wgid = (xcd < r ? xcd * (q + 1) : r * (q + 1) + (xcd - r) * q) + off; }
        const int nig = WGM * nN, gid = wgid / nig, fm = gid * WGM, gsz = (nM - fm) < WGM ? (nM - fm) : WGM;
        u.pm = fm + ((wgid % nig) % gsz); u.pn = (wgid % nig) / gsz; return true;
    }
};

struct Order2D {
    int c, nbn, nrounds, tail;
    __device__ void init(int M_, int N_, int c_) { c = c_; nbn = (N_ / BM) / 16; nrounds = ((M_ / BM) / 16) * nbn; tail = ((N_ / BM) % 16) ? 1 : 0; }
    __device__ bool next(int i, Unit& u) const {
        const int x = c & 7, j = c >> 3;
        if (i >= nrounds) { if (i >= nrounds + tail) return false; u.pm = 8 * x + (j & 7); u.pn = 16 * nbn + (j >> 3); return true; }
        const int xr = x & 3, xc = x >> 2, bm = i / nbn, bn = i % nbn;
        u.pm = 16 * bm + 4 * xr + (j & 3); u.pn = 16 * bn + 8 * xc + (j >> 2); return true;
    }
};
struct PanelOrder {
    int c;
    __device__ bool next(int i, Unit& u) const { if (i >= 2) return false; const int x = c & 7, j = c >> 3; u.pm = 8 * x + (j >> 3) + 4 * i; u.pn = j & 7; return true; }
};

template <class Epi, class Sched>
__device__ __forceinline__ void gemm_phase(LAS unsigned char* lds, const Gemm g, const Sched& S, const Epi& E) {
    int tid = threadIdx.x; asm volatile("" : "+v"(tid));
    const int wid = __builtin_amdgcn_readfirstlane(tid >> 6), lane = tid & 63, wr = wid >> 2, wc = wid & 3, fr = lane & 15, fq = lane >> 4;
    const int K = g.K, nt = K / BK, lda = g.lda;
    unsigned voffA[2], voffB[2];
#pragma unroll
    for (int i = 0; i < 2; ++i) { int R, C; stage_rc(tid * 16 + i * 8192, R, C); const int Rb = (R & ~31) + perm32(R & 31);
        voffA[i] = (unsigned)(R * lda + C) * 2u; voffB[i] = (unsigned)(Rb * K + C) * 2u; }
    const size_t kstep = (size_t)(BK * 2);
    const size_t hstepA = (size_t)HALF * lda * 2, tstepA = 2 * hstepA;
    const size_t hstepB = (size_t)HALF * K * 2, tstepB = 2 * hstepB;
    const unsigned ldsw = (unsigned)wid * 1024u;
    const int aoff = lds_byte(wr * 64 + fr, fq * 8), boff = lds_byte(wc * 32 + fr, fq * 8);
#define PG8_SA(b, h) (((b) * 2 + (h)) * HTB)
#define PG8_SB(b, h) ((4 + (b) * 2 + (h)) * HTB)
#define PG8_STAGE(bufoff, gbase, voff) do { _Pragma("unroll") for (int _i = 0; _i < 2; ++_i) \
        __builtin_amdgcn_global_load_lds((const unsigned*)((const char*)(gbase) + (voff)[_i]), (LAS unsigned*)(lds + (bufoff) + ldsw + _i * 8192), 16, 0, 0); } while (0)
#define PG8_LDA(dst, b, h) do { _Pragma("unroll") for (int m = 0; m < 4; ++m) _Pragma("unroll") for (int k = 0; k < 2; ++k) dst[m][k] = *(const LAS bf16x8*)(lds + PG8_SA(b, h) + aoff + m * 2048 + k * 1024); } while (0)
#define PG8_LDB(dst, b, h) do { _Pragma("unroll") for (int n = 0; n < 2; ++n) _Pragma("unroll") for (int k = 0; k < 2; ++k) dst[n][k] = *(const LAS bf16x8*)(lds + PG8_SB(b, h) + boff + n * 2048 + k * 1024); } while (0)
#define PG8_MMA(ai, bj, At, Bt) do { __builtin_amdgcn_s_setprio(1); _Pragma("unroll") for (int m = 0; m < 4; ++m) _Pragma("unroll") for (int n = 0; n < 2; ++n) _Pragma("unroll") for (int k = 0; k < 2; ++k) \
        acc[ai][bj][m][n] = __builtin_amdgcn_mfma_f32_16x16x32_bf16(Bt[n][k], At[m][k], acc[ai][bj][m][n], 0, 0, 0); __builtin_amdgcn_s_setprio(0); } while (0)
#define PG8_WAIT_V(n) asm volatile("s_waitcnt vmcnt(" #n ")" ::: "memory")
#define PG8_WAIT_L(n) asm volatile("s_waitcnt lgkmcnt(" #n ")" ::: "memory")
#define PG8_BAR __builtin_amdgcn_s_barrier()
#define PG8_SCHED __builtin_amdgcn_sched_barrier(0)
#define PG8_ABASE(u) ((const char*)g.A + (size_t)(u).pm * tstepA + (g.agrp ? (size_t)((u).pn / g.agrp) * 512 : (size_t)0))
#define PG8_BBASE(u) ((const char*)g.Bt + (size_t)(u).pn * tstepB)
    Unit cur, nxt; int ui = 0;
    if (!S.next(0, cur)) return;
    f32x4 acc[2][2][4][2];
#pragma unroll
    for (int a = 0; a < 2; ++a)
#pragma unroll
        for (int b = 0; b < 2; ++b)
#pragma unroll
            for (int m = 0; m < 4; ++m)
#pragma unroll
                for (int n = 0; n < 2; ++n) acc[a][b][m][n] = (f32x4){0.f, 0.f, 0.f, 0.f};
    bf16x8 At[4][2], B0[2][2], B1[2][2];
    const char* cA = PG8_ABASE(cur); const char* cB = PG8_BBASE(cur);
    PG8_STAGE(PG8_SB(0, 0), cB, voffB); PG8_STAGE(PG8_SB(0, 1), cB + hstepB, voffB); PG8_STAGE(PG8_SA(0, 0), cA, voffA); PG8_STAGE(PG8_SA(0, 1), cA + hstepA, voffA);
    if (wr == 1) PG8_BAR;
    PG8_WAIT_V(2); PG8_BAR;
    PG8_STAGE(PG8_SB(1, 0), cB + kstep, voffB); PG8_STAGE(PG8_SA(1, 0), cA + kstep, voffA); PG8_STAGE(PG8_SB(1, 1), cB + hstepB + kstep, voffB);
    PG8_WAIT_V(6); PG8_BAR;
    for (;;) {
        const bool has_next = S.next(ui + 1, nxt);
        const char* nA = has_next ? PG8_ABASE(nxt) : cA; const char* nB = has_next ? PG8_BBASE(nxt) : cB;
#pragma unroll 1
        for (int t = 0; t < nt; t += 2) {
            if constexpr (Epi::MIDT >= 0) {
                if (t == Epi::MIDT) { int fr_m = fr, fq_m = fq; asm volatile("" : "+v"(fr_m), "+v"(fq_m)); E.mid(acc, cur, wr, wc, fr_m, fq_m); }
            }
            const bool last = (t == nt - 2);
            const char* a1 = cA + (size_t)(t + 1) * kstep;
            const char* a2 = last ? nA : cA + (size_t)(t + 2) * kstep; const char* b2 = last ? nB : cB + (size_t)(t + 2) * kstep;
            const char* a3 = a2 + kstep; const char* b3 = b2 + kstep;
            PG8_LDB(B0, 0, 0); PG8_LDB(B1, 0, 1); PG8_SCHED; PG8_LDA(At, 0, 0); PG8_STAGE(PG8_SA(1, 1), a1 + hstepA, voffA);
            PG8_WAIT_V(8); PG8_WAIT_L(0); PG8_BAR; PG8_MMA(0, 0, At, B0); PG8_MMA(0, 1, At, B1); PG8_BAR; PG8_SCHED;
            PG8_LDA(At, 0, 1); PG8_STAGE(PG8_SB(0, 0), b2, voffB); PG8_STAGE(PG8_SB(0, 1), b2 + hstepB, voffB); PG8_STAGE(PG8_SA(0, 0), a2, voffA);
            PG8_WAIT_V(8); PG8_WAIT_L(0); PG8_BAR; PG8_MMA(1, 0, At, B0); PG8_MMA(1, 1, At, B1); PG8_BAR; PG8_SCHED;
            PG8_LDB(B0, 1, 0); PG8_LDB(B1, 1, 1); PG8_SCHED; PG8_LDA(At, 1, 0); PG8_STAGE(PG8_SA(0, 1), a2 + hstepA, voffA);
            PG8_WAIT_V(8); PG8_WAIT_L(0); PG8_BAR; PG8_MMA(0, 0, At, B0); PG8_MMA(0, 1, At, B1); PG8_BAR; PG8_SCHED;
            PG8_LDA(At, 1, 1); PG8_STAGE(PG8_SB(1, 0), b3, voffB); PG8_STAGE(PG8_SB(1, 1), b3 + hstepB, voffB); PG8_STAGE(PG8_SA(1, 0), a3, voffA);
            PG8_WAIT_V(8); PG8_WAIT_L(0); PG8_BAR; PG8_MMA(1, 0, At, B0); PG8_MMA(1, 1, At, B1); PG8_BAR; PG8_SCHED;
        }
        if (wr == 0) PG8_BAR;
        { int fr_e = fr, fq_e = fq; asm volatile("" : "+v"(fr_e), "+v"(fq_e));
          E(acc, cur, wr, wc, fr_e, fq_e); }
        if (!has_next) break;
#pragma unroll
        for (int a = 0; a < 2; ++a)
#pragma unroll
            for (int b = 0; b < 2; ++b)
#pragma unroll
                for (int m = 0; m < 4; ++m)
#pragma unroll
                    for (int n = 0; n < 2; ++n) acc[a][b][m][n] = (f32x4){0.f, 0.f, 0.f, 0.f};
        cur = nxt; cA = nA; cB = nB; ++ui;
        if (wr == 1) PG8_BAR;
    }
    PG8_WAIT_V(0);
    PG8_BAR;
#undef PG8_SA
#undef PG8_SB
#undef PG8_STAGE
#undef PG8_LDA
#undef PG8_LDB
#undef PG8_MMA
#undef PG8_WAIT_V
#undef PG8_WAIT_L
#undef PG8_BAR
#undef PG8_SCHED
#undef PG8_ABASE
#undef PG8_BBASE
}
}
using pg8::Unit;

#define EPI_ARGS const f32x4 (&acc)[2][2][4][2], const Unit& u, int wr, int wc, int fr, int fq
#define ROW_OF(ai, m) (u.pm * 256 + (ai) * 128 + wr * 64 + (m) * 16 + fr)

struct EpiProj {
    static constexpr int MIDT = -1;
    const float* zeros; const float* b_gate; bf16_t *upool, *ulru, *gelu_u, *gates;
    const float* cw; const float* cb; bf16_t* vout; float* headu; float* tailu;
    __device__ __forceinline__ void operator()(EPI_ARGS) const {
        const int pn = u.pn;
        if (pn >= 4 && pn < 12) {
            const int lane = fq * 16 + fr, s1 = (lane & 48) | ((fr - 1) & 15), s2 = (lane & 48) | ((fr - 2) & 15), s3 = (lane & 48) | ((fr - 3) & 15);
#pragma unroll
            for (int bj = 0; bj < 2; ++bj) {
                const int c0 = (pn - 4) * 256 + bj * 128 + wc * 32 + 8 * fq;
                f32x4 w0[2], w1[2], w2[2], w3[2], bb[2];
#pragma unroll
                for (int n = 0; n < 2; ++n) { w0[n] = *(const f32x4*)(cw + c0 + 4 * n); w1[n] = *(const f32x4*)(cw + LW + c0 + 4 * n); w2[n] = *(const f32x4*)(cw + 2 * LW + c0 + 4 * n); w3[n] = *(const f32x4*)(cw + 3 * LW + c0 + 4 * n); bb[n] = *(const f32x4*)(cb + c0 + 4 * n); }
#pragma unroll
                for (int ai = 0; ai < 2; ++ai) {
                    const int blk = u.pm * 4 + ai * 2 + wr;
                    f32x4 q1[2], q2[2], q3[2];
#pragma unroll
                    for (int n = 0; n < 2; ++n) { q1[n] = (f32x4){0.f, 0.f, 0.f, 0.f}; q2[n] = q1[n]; q3[n] = q1[n]; }
#pragma unroll
                    for (int m = 0; m < 4; ++m) {
                        const int row = ROW_OF(ai, m);
                        f32x4 o[2];
#pragma unroll
                        for (int n = 0; n < 2; ++n) {
                            const f32x4 gv = acc[ai][bj][m][n];
                            f32x4 r1, r2, r3, p1, p2, p3;
#pragma unroll
                            for (int j = 0; j < 4; ++j) { r1[j] = __shfl(gv[j], s1); r2[j] = __shfl(gv[j], s2); r3[j] = __shfl(gv[j], s3); }
#pragma unroll
                            for (int j = 0; j < 4; ++j) { p1[j] = fr >= 1 ? r1[j] : q1[n][j]; p2[j] = fr >= 2 ? r2[j] : q2[n][j]; p3[j] = fr >= 3 ? r3[j] : q3[n][j]; }
                            q1[n] = r1; q2[n] = r2; q3[n] = r3;
                            o[n] = bb[n] + w0[n] * p3 + w1[n] * p2 + w2[n] * p1 + w3[n] * gv;
                            if (m == 0 && fr < 3) *(f32x4*)(headu + ((size_t)blk * 3 + fr) * LW + c0 + 4 * n) = gv;
                            if (m == 3 && fr >= 13) *(f32x4*)(tailu + ((size_t)blk * 3 + (fr - 13)) * LW + c0 + 4 * n) = gv;
                        }
                        if (!(m == 0 && fr < 3)) {
                            u32x4 w; w.x = cvt_pk_bf16(o[0][0], o[0][1]); w.y = cvt_pk_bf16(o[0][2], o[0][3]); w.z = cvt_pk_bf16(o[1][0], o[1][1]); w.w = cvt_pk_bf16(o[1][2], o[1][3]);
                            *(u32x4*)(vout + (size_t)row * LW + c0) = w;
                        }
                    }
                }
            }
            return;
        }
        bf16_t* base; int ldc, colt, mode;
        if (pn < 4) { base = upool; ldc = PW; colt = pn * 256; mode = 0; }
        else if (pn < 12) { base = ulru; ldc = LW; colt = (pn - 4) * 256; mode = 0; }
        else if (pn < 20) { base = gelu_u; ldc = LW; colt = (pn - 12) * 256; mode = 1; }
        else { base = gates; ldc = 2 * D; colt = (pn - 20) * 256; mode = 2; }
        const int col0 = colt + wc * 32 + 8 * fq;
        const float* bsrc = (mode == 2) ? b_gate : zeros;
        f32x4 bv[2][2];
#pragma unroll
        for (int bj = 0; bj < 2; ++bj)
#pragma unroll
            for (int n = 0; n < 2; ++n) bv[bj][n] = *(const f32x4*)(bsrc + col0 + bj * 128 + 4 * n);
#pragma unroll
        for (int ai = 0; ai < 2; ++ai)
#pragma unroll
            for (int m = 0; m < 4; ++m) {
                const int row = ROW_OF(ai, m);
                bf16_t* rowp = base + (size_t)row * ldc + col0;
#pragma unroll
                for (int bj = 0; bj < 2; ++bj) {
                    f32x4 v0 = acc[ai][bj][m][0], v1 = acc[ai][bj][m][1];
                    v0 = v0 + bv[bj][0]; v1 = v1 + bv[bj][1];
                    if (mode == 1) { v0 = gelu4(v0); v1 = gelu4(v1); }
                    else if (mode == 2) { v0 = sigmoid4(v0); v1 = sigmoid4(v1); }
                    if (mode == 2) {
                        v0 = v0 * 255.0f; v1 = v1 * 255.0f; u32x2 w; w.x = 0u; w.y = 0u;
                        w.x = __builtin_amdgcn_cvt_pk_u8_f32(v0[0], 0, w.x); w.x = __builtin_amdgcn_cvt_pk_u8_f32(v0[1], 1, w.x); w.x = __builtin_amdgcn_cvt_pk_u8_f32(v0[2], 2, w.x); w.x = __builtin_amdgcn_cvt_pk_u8_f32(v0[3], 3, w.x);
                        w.y = __builtin_amdgcn_cvt_pk_u8_f32(v1[0], 0, w.y); w.y = __builtin_amdgcn_cvt_pk_u8_f32(v1[1], 1, w.y); w.y = __builtin_amdgcn_cvt_pk_u8_f32(v1[2], 2, w.y); w.y = __builtin_amdgcn_cvt_pk_u8_f32(v1[3], 3, w.y);
                        *(u32x2*)((unsigned char*)gates + (size_t)row * (2 * D) + col0 + bj * 128) = w;
                    } else {
                        u32x4 w; w.x = cvt_pk_bf16(v0[0], v0[1]); w.y = cvt_pk_bf16(v0[2], v0[3]); w.z = cvt_pk_bf16(v1[0], v1[1]); w.w = cvt_pk_bf16(v1[2], v1[3]);
                        *(u32x4*)(rowp + bj * 128) = w;
                    }
                }
            }
    }
};

struct EpiPool {
    static constexpr int MIDT = -1;
    const float* pool_scale; bf16_t* ypool;
    __device__ __forceinline__ void operator()(EPI_ARGS) const {
        const int col0 = u.pn * 256 + wc * 32 + 8 * fq;
        f32x4 sc[2][2];
#pragma unroll
        for (int bj = 0; bj < 2; ++bj)
#pragma unroll
            for (int n = 0; n < 2; ++n) sc[bj][n] = *(const f32x4*)(pool_scale + col0 + bj * 128 + 4 * n);
#pragma unroll
        for (int ai = 0; ai < 2; ++ai)
#pragma unroll
            for (int m = 0; m < 4; ++m) {
                bf16_t* rowp = ypool + (size_t)ROW_OF(ai, m) * KC + col0;
#pragma unroll
                for (int bj = 0; bj < 2; ++bj) {
                    const f32x4 v0 = acc[ai][bj][m][0] * sc[bj][0], v1 = acc[ai][bj][m][1] * sc[bj][1];
                    u32x4 w; w.x = cvt_pk_bf16(v0[0], v0[1]); w.y = cvt_pk_bf16(v0[2], v0[3]); w.z = cvt_pk_bf16(v1[0], v1[1]); w.w = cvt_pk_bf16(v1[2], v1[3]);
                    *(u32x4*)(rowp + bj * 128) = w;
                }
            }
    }
};

struct EpiLru {
    static constexpr int MIDT = -1;
    const bf16_t* V; const float* b_a; const float* b_i; const float* sp8; unsigned* AB;
    __device__ __forceinline__ void operator()(EPI_ARGS) const {
        const int c0 = (u.pn >> 1) * 256 + (u.pn & 1) * 128 + wc * 32 + 8 * fq;
        u32x4 vv[2][4];
#pragma unroll
        for (int ai = 0; ai < 2; ++ai)
#pragma unroll
            for (int m = 0; m < 4; ++m) vv[ai][m] = *(const u32x4*)(V + (size_t)ROW_OF(ai, m) * LW + c0);
        f32x4 ba[2], bi[2], sp[2];
#pragma unroll
        for (int n = 0; n < 2; ++n) { ba[n] = *(const f32x4*)(b_a + c0 + 4 * n); bi[n] = *(const f32x4*)(b_i + c0 + 4 * n); sp[n] = *(const f32x4*)(sp8 + c0 + 4 * n); }
#pragma unroll
        for (int ai = 0; ai < 2; ++ai)
#pragma unroll
            for (int m = 0; m < 4; ++m) {
                const int row = ROW_OF(ai, m);
#pragma unroll
                for (int n = 0; n < 2; ++n) {
                    const unsigned w0 = n ? vv[ai][m].z : vv[ai][m].x, w1 = n ? vv[ai][m].w : vv[ai][m].y;
                    const f32x4 vx = (f32x4){bf_lo(w0), bf_hi(w0), bf_lo(w1), bf_hi(w1)};
                    const f32x4 r = sigmoid4(acc[ai][0][m][n] + ba[n]), ig = sigmoid4(acc[ai][1][m][n] + bi[n]);
                    const f32x4 la = sp[n] * r * (-1.4426950409f);
                    f32x4 av;
#pragma unroll
                    for (int j = 0; j < 4; ++j) av[j] = __builtin_amdgcn_exp2f(la[j]);
                    const f32x4 om = 1.0f - av * av; f32x4 sq;
#pragma unroll
                    for (int j = 0; j < 4; ++j) sq[j] = __builtin_amdgcn_sqrtf(om[j]);
                    const f32x4 bx = sq * ig * vx;
                    u32x4 w; w.x = cvt_pk_bf16(la[0], bx[0]); w.y = cvt_pk_bf16(la[1], bx[1]); w.z = cvt_pk_bf16(la[2], bx[2]); w.w = cvt_pk_bf16(la[3], bx[3]);
                    *(u32x4*)(AB + (size_t)row * LW + c0 + 4 * n) = w;
                }
            }
    }
};

#define UNPKG(q, lo, hi) const f32x4 lo = (f32x4){(float)((q).x & 0xff), (float)(((q).x >> 8) & 0xff), (float)(((q).x >> 16) & 0xff), (float)((q).x >> 24)} * (1.0f / 255.0f), hi = (f32x4){(float)((q).y & 0xff), (float)(((q).y >> 8) & 0xff), (float)(((q).y >> 16) & 0xff), (float)((q).y >> 24)} * (1.0f / 255.0f)
#define UNPK4(q, lo, hi) const f32x4 lo = (f32x4){bf_lo((q).x), bf_hi((q).x), bf_lo((q).y), bf_hi((q).y)}, hi = (f32x4){bf_lo((q).z), bf_hi((q).z), bf_lo((q).w), bf_hi((q).w)}
struct EpiMerge {
    static constexpr int MIDT = PW / 64;
    const unsigned char* gates; bf16_t* merged;
    __device__ __forceinline__ void mid(f32x4 (&acc)[2][2][4][2], const Unit& u, int wr, int wc, int fr, int fq) const {
        const int col0 = u.pn * 256 + wc * 32 + 8 * fq;
        u32x2 ac[2], bc[2], an[2], bn[2];
#pragma unroll
        for (int bj = 0; bj < 2; ++bj) { const unsigned char* p = gates + (size_t)ROW_OF(0, 0) * (2 * D) + col0 + bj * 128; ac[bj] = *(const u32x2*)p; bc[bj] = *(const u32x2*)(p + D); }
#pragma unroll
        for (int g = 0; g < 8; ++g) {
            const int ai = g >> 2, m = g & 3;
            if (g < 7) {
#pragma unroll
                for (int bj = 0; bj < 2; ++bj) { const unsigned char* p = gates + (size_t)ROW_OF((g + 1) >> 2, (g + 1) & 3) * (2 * D) + col0 + bj * 128; an[bj] = *(const u32x2*)p; bn[bj] = *(const u32x2*)(p + D); }
            }
#pragma unroll
            for (int bj = 0; bj < 2; ++bj) {
                const unsigned a0 = ac[bj].x, a1 = ac[bj].y, b0 = bc[bj].x, b1 = bc[bj].y;
                f32x4 r0, r1;
#pragma unroll
                for (int j = 0; j < 4; ++j) {
                    r0[j] = (float)((a0 >> (8 * j)) & 0xff) * __builtin_amdgcn_rcpf(fmaxf((float)((b0 >> (8 * j)) & 0xff), 0.5f));
                    r1[j] = (float)((a1 >> (8 * j)) & 0xff) * __builtin_amdgcn_rcpf(fmaxf((float)((b1 >> (8 * j)) & 0xff), 0.5f));
                }
                acc[ai][bj][m][0] = acc[ai][bj][m][0] * r0; acc[ai][bj][m][1] = acc[ai][bj][m][1] * r1;
            }
            if (g < 7) { ac[0] = an[0]; ac[1] = an[1]; bc[0] = bn[0]; bc[1] = bn[1]; }
        }
    }
    __device__ __forceinline__ void operator()(EPI_ARGS) const {
        const int col0 = u.pn * 256 + wc * 32 + 8 * fq;
        u32x2 gc[2], gn[2];
#pragma unroll
        for (int bj = 0; bj < 2; ++bj) gc[bj] = *(const u32x2*)(gates + (size_t)ROW_OF(0, 0) * (2 * D) + D + col0 + bj * 128);
#pragma unroll
        for (int g = 0; g < 8; ++g) {
            const int ai = g >> 2, m = g & 3, row = ROW_OF(ai, m);
            if (g < 7) {
#pragma unroll
                for (int bj = 0; bj < 2; ++bj) gn[bj] = *(const u32x2*)(gates + (size_t)ROW_OF((g + 1) >> 2, (g + 1) & 3) * (2 * D) + D + col0 + bj * 128);
            }
#pragma unroll
            for (int bj = 0; bj < 2; ++bj) {
                const unsigned b0 = gc[bj].x, b1 = gc[bj].y;
                f32x4 g0, g1;
#pragma unroll
                for (int j = 0; j < 4; ++j) { g0[j] = fmaxf((float)((b0 >> (8 * j)) & 0xff), 0.5f) * (1.0f / 255.0f); g1[j] = fmaxf((float)((b1 >> (8 * j)) & 0xff), 0.5f) * (1.0f / 255.0f); }
                const f32x4 v0 = acc[ai][bj][m][0] * g0, v1 = acc[ai][bj][m][1] * g1;
                u32x4 w; w.x = cvt_pk_bf16(v0[0], v0[1]); w.y = cvt_pk_bf16(v0[2], v0[3]); w.z = cvt_pk_bf16(v1[0], v1[1]); w.w = cvt_pk_bf16(v1[2], v1[3]);
                *(u32x4*)(merged + (size_t)row * D + col0 + bj * 128) = w;
            }
            if (g < 7) { gc[0] = gn[0]; gc[1] = gn[1]; }
        }
    }
};

struct EpiResid1 {
    static constexpr int MIDT = -1;
    const float* xin; bf16_t* xb; float* ss;
    __device__ __forceinline__ void operator()(EPI_ARGS) const {
        const int col0 = u.pn * 256 + wc * 32 + 8 * fq;
        f32x4 xc[2][2], xn[2][2];
#pragma unroll
        for (int bj = 0; bj < 2; ++bj) { const size_t off = (size_t)ROW_OF(0, 0) * D + col0 + bj * 128; xc[bj][0] = *(const f32x4*)(xin + off); xc[bj][1] = *(const f32x4*)(xin + off + 4); }
#pragma unroll
        for (int g = 0; g < 8; ++g) {
            const int ai = g >> 2, m = g & 3, row = ROW_OF(ai, m); float s = 0.f;
            if (g < 7) {
#pragma unroll
                for (int bj = 0; bj < 2; ++bj) { const size_t off = (size_t)ROW_OF((g + 1) >> 2, (g + 1) & 3) * D + col0 + bj * 128; xn[bj][0] = *(const f32x4*)(xin + off); xn[bj][1] = *(const f32x4*)(xin + off + 4); }
            }
#pragma unroll
            for (int bj = 0; bj < 2; ++bj) {
                const size_t off = (size_t)row * D + col0 + bj * 128;
                const f32x4 v0 = xc[bj][0] + acc[ai][bj][m][0], v1 = xc[bj][1] + acc[ai][bj][m][1];
                s += (v0[0] * v0[0] + v0[1] * v0[1]) + (v0[2] * v0[2] + v0[3] * v0[3]) + (v1[0] * v1[0] + v1[1] * v1[1]) + (v1[2] * v1[2] + v1[3] * v1[3]);
                u32x4 w; w.x = cvt_pk_bf16(v0[0], v0[1]); w.y = cvt_pk_bf16(v0[2], v0[3]); w.z = cvt_pk_bf16(v1[0], v1[1]); w.w = cvt_pk_bf16(v1[2], v1[3]); *(u32x4*)(xb + off) = w;
            }
            s += __shfl_xor(s, 16); s += __shfl_xor(s, 32);
            if (fq == 0) __hip_atomic_fetch_add(ss + row, s, __ATOMIC_RELAXED, __HIP_MEMORY_SCOPE_AGENT);
            if (g < 7) {
#pragma unroll
                for (int bj = 0; bj < 2; ++bj) { xc[bj][0] = xn[bj][0]; xc[bj][1] = xn[bj][1]; }
            }
        }
    }
};
struct EpiResid2 {
    static constexpr int MIDT = -1;
    bf16_t* xb; float* ss;
    __device__ __forceinline__ void operator()(EPI_ARGS) const {
        const int col0 = u.pn * 256 + wc * 32 + 8 * fq;
        u32x4 xc[2], xn[2];
#pragma unroll
        for (int bj = 0; bj < 2; ++bj) xc[bj] = *(const u32x4*)(xb + (size_t)ROW_OF(0, 0) * D + col0 + bj * 128);
#pragma unroll
        for (int g = 0; g < 8; ++g) {
            const int ai = g >> 2, m = g & 3, row = ROW_OF(ai, m); float s = 0.f;
            if (g < 7) {
#pragma unroll
                for (int bj = 0; bj < 2; ++bj) xn[bj] = *(const u32x4*)(xb + (size_t)ROW_OF((g + 1) >> 2, (g + 1) & 3) * D + col0 + bj * 128);
            }
#pragma unroll
            for (int bj = 0; bj < 2; ++bj) {
                UNPK4(xc[bj], x0, x1);
                const f32x4 v0 = x0 + acc[ai][bj][m][0], v1 = x1 + acc[ai][bj][m][1];
                s += (v0[0] * v0[0] + v0[1] * v0[1]) + (v0[2] * v0[2] + v0[3] * v0[3]) + (v1[0] * v1[0] + v1[1] * v1[1]) + (v1[2] * v1[2] + v1[3] * v1[3]);
                u32x4 w; w.x = cvt_pk_bf16(v0[0], v0[1]); w.y = cvt_pk_bf16(v0[2], v0[3]); w.z = cvt_pk_bf16(v1[0], v1[1]); w.w = cvt_pk_bf16(v1[2], v1[3]);
                *(u32x4*)(xb + (size_t)row * D + col0 + bj * 128) = w;
            }
            s += __shfl_xor(s, 16); s += __shfl_xor(s, 32);
            if (fq == 0) __hip_atomic_fetch_add(ss + row, s, __ATOMIC_RELAXED, __HIP_MEMORY_SCOPE_AGENT);
            if (g < 7) { xc[0] = xn[0]; xc[1] = xn[1]; }
        }
    }
};

struct EpiFinal {
    static constexpr int MIDT = -1;
    const bf16_t* xb; float* ss; unsigned* cnt; const float* gfin; float* out;
    __device__ __forceinline__ void operator()(f32x4 (&acc)[2][2][4][2], const Unit& u, int wr, int wc, int fr, int fq) const {
        const int col0 = u.pn * 256 + wc * 32 + 8 * fq;
        u32x4 xc[2], xn[2];
#pragma unroll
        for (int bj = 0; bj < 2; ++bj) xc[bj] = *(const u32x4*)(xb + (size_t)ROW_OF(0, 0) * D + col0 + bj * 128);
#pragma unroll
        for (int g = 0; g < 8; ++g) {
            const int ai = g >> 2, m = g & 3, row = ROW_OF(ai, m); float s = 0.f;
            if (g < 7) {
#pragma unroll
                for (int bj = 0; bj < 2; ++bj) xn[bj] = *(const u32x4*)(xb + (size_t)ROW_OF((g + 1) >> 2, (g + 1) & 3) * D + col0 + bj * 128);
            }
#pragma unroll
            for (int bj = 0; bj < 2; ++bj) {
                UNPK4(xc[bj], x0, x1);
                const f32x4 v0 = x0 + acc[ai][bj][m][0], v1 = x1 + acc[ai][bj][m][1];
                acc[ai][bj][m][0] = v0; acc[ai][bj][m][1] = v1;
                s += (v0[0] * v0[0] + v0[1] * v0[1]) + (v0[2] * v0[2] + v0[3] * v0[3]) + (v1[0] * v1[0] + v1[1] * v1[1]) + (v1[2] * v1[2] + v1[3] * v1[3]);
            }
            s += __shfl_xor(s, 16); s += __shfl_xor(s, 32);
            if (fq == 0) __hip_atomic_fetch_add(ss + row, s, __ATOMIC_RELAXED, __HIP_MEMORY_SCOPE_AGENT);
            if (g < 7) { xc[0] = xn[0]; xc[1] = xn[1]; }
        }
        asm volatile("s_waitcnt vmcnt(0)" ::: "memory"); __builtin_amdgcn_s_barrier();
        if (threadIdx.x == 0) {
            __hip_atomic_fetch_add(cnt + u.pm, 1u, __ATOMIC_RELAXED, __HIP_MEMORY_SCOPE_AGENT);
            unsigned sp = 0;
            while (__hip_atomic_load(cnt + u.pm, __ATOMIC_RELAXED, __HIP_MEMORY_SCOPE_AGENT) < 8u) { __builtin_amdgcn_s_sleep(1); if (++sp > (1u << 22)) break; }
        }
        asm volatile("s_waitcnt vmcnt(0) lgkmcnt(0)" ::: "memory"); __builtin_amdgcn_s_barrier(); asm volatile("" ::: "memory");
        float rs[8];
#pragma unroll
        for (int g = 0; g < 8; ++g) rs[g] = __hip_atomic_load(ss + ROW_OF(g >> 2, g & 3), __ATOMIC_RELAXED, __HIP_MEMORY_SCOPE_AGENT);
        f32x4 gf[2][2];
#pragma unroll
        for (int bj = 0; bj < 2; ++bj) { gf[bj][0] = *(const f32x4*)(gfin + col0 + bj * 128); gf[bj][1] = *(const f32x4*)(gfin + col0 + bj * 128 + 4); }
#pragma unroll
        for (int g = 0; g < 8; ++g) {
            const int ai = g >> 2, m = g & 3, row = ROW_OF(ai, m);
            const float r = 1.0f / sqrtf(rs[g] * (1.0f / D) + EPS);
#pragma unroll
            for (int bj = 0; bj < 2; ++bj) {
                float* op = out + (size_t)row * D + col0 + bj * 128;
                *(f32x4*)(op) = acc[ai][bj][m][0] * r * gf[bj][0]; *(f32x4*)(op + 4) = acc[ai][bj][m][1] * r * gf[bj][1];
            }
        }
    }
};

struct EpiUp {
    static constexpr int MIDT = -1;
    const float* ss2; const float* cw; const float* cb; bf16_t* act; float* tailg; float* headg; float* headv;
    __device__ __forceinline__ void operator()(EPI_ARGS) const {
        const int f0 = u.pn * 128 + wc * 32 + 8 * fq;
        const int lane = fq * 16 + fr, src1 = (lane & 48) | ((fr - 1) & 15), src2 = (lane & 48) | ((fr - 2) & 15);
        f32x4 w0[2], w1[2], w2[2], bb[2];
#pragma unroll
        for (int n = 0; n < 2; ++n) { w0[n] = *(const f32x4*)(cw + f0 + 4 * n); w1[n] = *(const f32x4*)(cw + FF + f0 + 4 * n); w2[n] = *(const f32x4*)(cw + 2 * FF + f0 + 4 * n); bb[n] = *(const f32x4*)(cb + f0 + 4 * n); }
        float rsv[2][4];
#pragma unroll
        for (int ai = 0; ai < 2; ++ai)
#pragma unroll
            for (int m = 0; m < 4; ++m) rsv[ai][m] = ss2[ROW_OF(ai, m)];
#pragma unroll
        for (int ai = 0; ai < 2; ++ai) {
            const int blk = u.pm * 4 + ai * 2 + wr;
            f32x4 q1[2], q2[2];
#pragma unroll
            for (int n = 0; n < 2; ++n) { q1[n] = (f32x4){0.f, 0.f, 0.f, 0.f}; q2[n] = (f32x4){0.f, 0.f, 0.f, 0.f}; }
#pragma unroll
            for (int m = 0; m < 4; ++m) {
                const int row = ROW_OF(ai, m);
                const float rs = __builtin_amdgcn_rsqf(rsv[ai][m] * (1.0f / D) + EPS);
                f32x4 o[2];
#pragma unroll
                for (int n = 0; n < 2; ++n) {
                    const f32x4 gv = acc[ai][0][m][n] * rs, vv = acc[ai][1][m][n] * rs;
                    f32x4 r1, r2;
#pragma unroll
                    for (int j = 0; j < 4; ++j) { r1[j] = __shfl(gv[j], src1); r2[j] = __shfl(gv[j], src2); }
                    f32x4 p1, p2;
#pragma unroll
                    for (int j = 0; j < 4; ++j) { p1[j] = fr >= 1 ? r1[j] : q1[n][j]; p2[j] = fr >= 2 ? r2[j] : q2[n][j]; }
                    q1[n] = r1; q2[n] = r2;
                    const f32x4 cv = bb[n] + w0[n] * p2 + w1[n] * p1 + w2[n] * gv;
                    o[n] = gelu4(cv) * vv;
                    if (m == 0 && fr < 2) { const size_t so = ((size_t)blk * 2 + fr) * FF + f0 + 4 * n; *(f32x4*)(headg + so) = gv; *(f32x4*)(headv + so) = vv; }
                    if (m == 3 && fr >= 14) { const size_t so = ((size_t)blk * 2 + (fr - 14)) * FF + f0 + 4 * n; *(f32x4*)(tailg + so) = gv; }
                }
                if (!(m == 0 && fr < 2)) {
                    u32x4 w; w.x = cvt_pk_bf16(o[0][0], o[0][1]); w.y = cvt_pk_bf16(o[0][2], o[0][3]); w.z = cvt_pk_bf16(o[1][0], o[1][1]); w.w = cvt_pk_bf16(o[1][2], o[1][3]);
                    *(u32x4*)(act + (size_t)row * FF + f0) = w;
                }
            }
        }
    }
};

__device__ __forceinline__ void tr_tile(const float* src, int ldw, const float* ksc, bf16_t* dst, int ldd, LAS float* scr, int lane) {
    float v[32];
#pragma unroll
    for (int i = 0; i < 32; ++i) v[i] = src[(size_t)(2 * i + (lane >> 5)) * ldw + (lane & 31)];
#pragma unroll
    for (int i = 0; i < 32; ++i) scr[(2 * i + (lane >> 5)) * 33 + (lane & 31)] = v[i];
    LDS_WAIT();
    const int c = lane & 7;
    f32x4 k0 = (f32x4){1.f, 1.f, 1.f, 1.f}, k1 = k0;
    if (ksc) { k0 = *(const f32x4*)(ksc + 8 * c); k1 = *(const f32x4*)(ksc + 8 * c + 4); }
#pragma unroll
    for (int j = 0; j < 4; ++j) { const int n = (lane >> 3) + 8 * j; const LAS float* s = scr + (8 * c) * 33 + n;
        u32x4 o; o.x = cvt_pk_bf16(s[0 * 33] * k0[0], s[1 * 33] * k0[1]); o.y = cvt_pk_bf16(s[2 * 33] * k0[2], s[3 * 33] * k0[3]);
        o.z = cvt_pk_bf16(s[4 * 33] * k1[0], s[5 * 33] * k1[1]); o.w = cvt_pk_bf16(s[6 * 33] * k1[2], s[7 * 33] * k1[3]);
        *(u32x4*)(dst + (size_t)n * ldd + 8 * c) = o; }
    LDS_WAIT();
}
__device__ __forceinline__ void tr_plain(const float* W, int K, int N, const float* ksc, bf16_t* WT, int item, LAS float* scr, int lane) {
    const int nblk = N / 32, kb = item / nblk, nb = item % nblk, k0 = kb * 64, n0 = nb * 32;
    tr_tile(W + (size_t)k0 * N + n0, N, ksc ? ksc + k0 : nullptr, WT + (size_t)n0 * K + k0, K, scr, lane);
}


#define UNPK8(q, f) const float f[8] = {bf_lo((q).x), bf_hi((q).x), bf_lo((q).y), bf_hi((q).y), bf_lo((q).z), bf_hi((q).z), bf_lo((q).w), bf_hi((q).w)}
template <int W> __device__ __forceinline__ void pool_run(const bf16_t* up, bf16_t* dp, int t0) {
    u32x4 q[W + 15];
#pragma unroll
    for (int i = 0; i < W + 15; ++i) { const int dt = i - (W - 1); const bool ok = (t0 + dt >= 0); const u32x4 v = *(const u32x4*)(up + (ptrdiff_t)(ok ? dt : 0) * PW); q[i] = ok ? v : (u32x4){0u, 0u, 0u, 0u}; }
    float s[8];
#pragma unroll
    for (int e = 0; e < 8; ++e) s[e] = 0.f;
#pragma unroll
    for (int i = 0; i < W - 1; ++i) { UNPK8(q[i], f);
#pragma unroll
        for (int e = 0; e < 8; ++e) s[e] += f[e]; }
#pragma unroll
    for (int j = 0; j < 16; ++j) {
        UNPK8(q[j + W - 1], cur);
#pragma unroll
        for (int e = 0; e < 8; ++e) s[e] += cur[e];
        const int cnt = (t0 + j + 1) < W ? (t0 + j + 1) : W; const float inv = 1.0f / (float)cnt;
        u32x4 o; o.x = cvt_pk_bf16(s[0] * inv - cur[0], s[1] * inv - cur[1]); o.y = cvt_pk_bf16(s[2] * inv - cur[2], s[3] * inv - cur[3]);
        o.z = cvt_pk_bf16(s[4] * inv - cur[4], s[5] * inv - cur[5]); o.w = cvt_pk_bf16(s[6] * inv - cur[6], s[7] * inv - cur[7]);
        *(u32x4*)(dp + (size_t)j * PW) = o;
        UNPK8(q[j], old);
#pragma unroll
        for (int e = 0; e < 8; ++e) s[e] -= old[e];
    }
}

struct Args { const float* in[22]; float* out; unsigned char* ws; };
#ifndef PH_MASK
#define PH_MASK 0xFFFF
#endif
#define PH(k) if constexpr ((PH_MASK >> (k)) & 1)
#ifndef REP_MASK
#define REP_MASK 0
#endif
#define REPS(k) for (int rep_ = 0; rep_ < 1 + ((REP_MASK >> (k)) & 1); ++rep_)

__global__ void __launch_bounds__(NTHR, 2) hybrid_block_fwd(Args a) {
    extern __shared__ __attribute__((aligned(16))) unsigned char lds_raw[];
    LAS unsigned char* lds = (LAS unsigned char*)lds_raw;
    cg::grid_group grid = cg::this_grid();
#define IDS() int tid = threadIdx.x; asm volatile("" : "+v"(tid)); const int lane = tid & 63, wave = __builtin_amdgcn_readfirstlane(tid >> 6); const int gtid = blockIdx.x * NTHR + tid, gw = blockIdx.x * (NTHR / 64) + wave; LAS float* scr = (LAS float*)(lds + wave * 16384); (void)lane; (void)gtid; (void)gw; (void)scr;
    unsigned char* ws = a.ws;
    volatile LAS unsigned* MISC = (volatile LAS unsigned*)(lds + 131072);
    if (threadIdx.x < 64) MISC[threadIdx.x] = 0u;
    unsigned* BARW = (unsigned*)(ws + WS_BAR);
    unsigned* PCNT = (unsigned*)(ws + WS_CNT);
    __syncthreads();
    if (ws == nullptr) grid.sync();
    const XcdBarrier xbar = xcd_barrier_post(BARW, MISC + 8);
    const float* x = a.in[0]; const float* g_mix = a.in[1]; const float* w_in = a.in[2]; const float* b_gate = a.in[3];
    const float* w_pool = a.in[4]; const float* pool_scale = a.in[5]; const float* lru_conv_w = a.in[6]; const float* lru_conv_b = a.in[7];
    const float* w_a = a.in[8]; const float* b_a = a.in[9]; const float* w_i = a.in[10]; const float* b_i = a.in[11]; const float* lru_lambda = a.in[12];
    const float* w_pool_proj = a.in[13]; const float* w_lru_proj = a.in[14]; const float* w_out = a.in[15]; const float* g_mlp = a.in[16];
    const float* w_up = a.in[17]; const float* ffn_conv_w = a.in[18]; const float* ffn_conv_b = a.in[19]; const float* w_down = a.in[20]; const float* g_final = a.in[21];
    float* out = a.out;
    float* RSTD1 = (float*)(ws + WS_RSTD1); float* SS2 = (float*)(ws + WS_SS2); float* SS3 = (float*)(ws + WS_SS3); float* SP8 = (float*)(ws + WS_SP8);
    float* AGGP = (float*)(ws + WS_AGGP); float* AGGH = (float*)(ws + WS_AGGH);
    bf16_t* WT_POOL = (bf16_t*)(ws + WS_WT_POOL); bf16_t* WT_GATE = (bf16_t*)(ws + WS_WT_GATE); bf16_t* WT_CAT = (bf16_t*)(ws + WS_WT_PP);
    bf16_t* WT_OUT = (bf16_t*)(ws + WS_WT_OUT); bf16_t* WT_IN = (bf16_t*)(ws + WS_WT_IN);
    bf16_t* WT_UP = (bf16_t*)(ws + WS_WT_UP); bf16_t* WT_DOWN = (bf16_t*)(ws + WS_WT_DOWN);
    bf16_t* XB = (bf16_t*)(ws + WS_XB); bf16_t* DD = (bf16_t*)(ws + WS_DD); bf16_t* VV = (bf16_t*)(ws + WS_V2); float* HEADU = (float*)(ws + WS_HEADU); float* TAILU = (float*)(ws + WS_TAILU); bf16_t* YCAT = (bf16_t*)(ws + WS_YCAT);
    bf16_t* UPOOL = (bf16_t*)(ws + WS_UPOOL); bf16_t* GELU_U = (bf16_t*)(ws + WS_GELU); bf16_t* X1B = (bf16_t*)(ws + WS_X1B);
    bf16_t* GATES = (bf16_t*)(ws + WS_GATES); bf16_t* ULRU = (bf16_t*)(ws + WS_ULRU); bf16_t* BX = (bf16_t*)(ws + WS_BX); bf16_t* MERGED = (bf16_t*)(ws + WS_MERGED);
    bf16_t* ACT = (bf16_t*)(ws + WS_ACT); float* TAILG = (float*)(ws + WS_TAILG); float* HEADG = (float*)(ws + WS_HEADG); float* HEADV = (float*)(ws + WS_HEADV);
    float* AF = out;

    PH(0) REPS(0) { IDS();
    for (int i = gtid; i < 2 * M; i += NT) SS2[i] = 0.f;
    for (int i = gtid; i < LW; i += NT) SP8[i] = 8.0f * log1pf(expf(-lru_lambda[i]));
    {
        constexpr int I_IN = (D / 64) * (INW / 32), I_PP = (PW / 64) * (D / 32), I_LP = (LW / 64) * (D / 32), I_OUT = (D / 64) * (D / 32), I_POOL = 4 * 4 * 8, I_GATE = 4 * 128;
        constexpr int NITEMS = I_IN + I_PP + I_LP + I_OUT + I_POOL + I_GATE;
        for (int it = gw; it < NITEMS; it += NWV) {
            int r = it;
            if (r < I_IN) { tr_plain(w_in, D, INW, g_mix, WT_IN, r, scr, lane); continue; } r -= I_IN;
            if (r < I_PP) { const int kb = r / (D / 32), nb = r % (D / 32); tr_tile(w_pool_proj + (size_t)kb * 64 * D + nb * 32, D, nullptr, WT_CAT + (size_t)nb * 32 * KC + kb * 64, KC, scr, lane); continue; } r -= I_PP;
            if (r < I_LP) { const int kb = r / (D / 32), nb = r % (D / 32); tr_tile(w_lru_proj + (size_t)kb * 64 * D + nb * 32, D, nullptr, WT_CAT + (size_t)nb * 32 * KC + PW + kb * 64, KC, scr, lane); continue; } r -= I_LP;
            if (r < I_OUT) { tr_plain(w_out, D, D, nullptr, WT_OUT, r, scr, lane); continue; } r -= I_OUT;
            if (r < I_POOL) { const int g = r >> 5; tr_plain(w_pool + (size_t)g * 65536, 256, 256, nullptr, WT_POOL + (size_t)g * 65536, r & 31, scr, lane); continue; } r -= I_POOL;
            {
                const int kb = r >> 7, nb = r & 127, n0 = nb * 32, pn = n0 >> 8, bj = (n0 >> 7) & 1, j0 = n0 & 127, k0 = kb * 64;
                const float* W = (bj ? w_i : w_a) + (size_t)(pn >> 1) * 65536;
                tr_tile(W + (size_t)k0 * 256 + (pn & 1) * 128 + j0, 256, nullptr, WT_GATE + (size_t)n0 * 256 + k0, 256, scr, lane);
            }
        }
        for (int row = gw; row < M; row += NWV) {
            const f32x4* xr = (const f32x4*)(x + (size_t)row * D) + lane; f32x4 v[8]; float s = 0.f;
#pragma unroll
            for (int j = 0; j < 8; ++j) { v[j] = xr[64 * j]; s += (v[j][0] * v[j][0] + v[j][1] * v[j][1]) + (v[j][2] * v[j][2] + v[j][3] * v[j][3]); }
            s = wave_sum(s);
            const float rs1 = 1.0f / sqrtf(s * (1.0f / D) + EPS);
            u32x2* o = (u32x2*)(XB + (size_t)row * D) + lane;
#pragma unroll
            for (int j = 0; j < 8; ++j) { u32x2 w; w.x = cvt_pk_bf16(v[j][0] * rs1, v[j][1] * rs1); w.y = cvt_pk_bf16(v[j][2] * rs1, v[j][3] * rs1); o[64 * j] = w; }
        }
    }
    }
    xcd_barrier(xbar);

    PH(1) REPS(1)
    {
        pg8::Gemm g{XB, WT_IN, D, D, 0}; pg8::Order2D S; S.init(M, INW, (int)blockIdx.x);
        EpiProj E{SS2, b_gate, UPOOL, ULRU, GELU_U, GATES, lru_conv_w, lru_conv_b, VV, HEADU, TAILU};
        pg8::gemm_phase(lds, g, S, E);
    }
    xcd_barrier(xbar);

    PH(2) REPS(2)
    {
        { IDS();
            { pg8::StaticOrder S0; S0.init(M, PW, NWG, (int)blockIdx.x); pg8::Unit uu;
              if (S0.next(0, uu)) {
                  const int grp = uu.pn, r0 = uu.pm * 256 + (tid >> 5) * 16, c = grp * 256 + (tid & 31) * 8, t0 = r0 & (SEQ - 1);
                  const bf16_t* up = UPOOL + (size_t)r0 * PW + c; bf16_t* dp = DD + (size_t)r0 * PW + c;
                  if (grp == 0) pool_run<2>(up, dp, t0); else if (grp == 1) pool_run<4>(up, dp, t0); else if (grp == 2) pool_run<8>(up, dp, t0); else pool_run<16>(up, dp, t0);
              } }
            { pg8::StaticOrder S1; S1.init(M, 2 * LW, NWG, (int)blockIdx.x);
              for (int ui = 0; ui < 4; ++ui) {
                  pg8::Unit uu; if (!S1.next(ui, uu)) break;
                  const int hcol = (uu.pn >> 1) * 256;
                  for (int idx = tid; idx < 4 * 3 * 64; idx += NTHR) {
                      const int c4 = hcol + (idx & 63) * 4, rr = (idx >> 6) % 3, blk = uu.pm * 4 + (idx >> 6) / 3;
                      const bool seq0 = (blk & 127) == 0; const int pb = seq0 ? blk : blk - 1; const size_t row = (size_t)blk * 64 + rr;
                      const float* H = HEADU + (size_t)blk * 3 * LW + c4; const float* T = TAILU + (size_t)pb * 3 * LW + c4;
                      const f32x4 z = (f32x4){0.f, 0.f, 0.f, 0.f};
                      const f32x4 t0 = *(const f32x4*)(T), t1 = *(const f32x4*)(T + LW), t2 = *(const f32x4*)(T + 2 * LW);
                      const f32x4 h0 = *(const f32x4*)(H), h1 = *(const f32x4*)(H + (rr >= 1 ? LW : 0)), h2 = *(const f32x4*)(H + (rr >= 2 ? 2 * LW : 0));
                      const f32x4 T0 = seq0 ? z : t0, T1 = seq0 ? z : t1, T2 = seq0 ? z : t2;
                      const f32x4 u0 = rr == 0 ? h0 : (rr == 1 ? h1 : h2);
                      const f32x4 u1 = rr == 0 ? T2 : (rr == 1 ? h0 : h1);
                      const f32x4 u2 = rr == 0 ? T1 : (rr == 1 ? T2 : h0);
                      const f32x4 u3 = rr == 0 ? T0 : (rr == 1 ? T1 : T2);
                      const f32x4 v = *(const f32x4*)(lru_conv_b + c4) + *(const f32x4*)(lru_conv_w + c4) * u3 + *(const f32x4*)(lru_conv_w + LW + c4) * u2 + *(const f32x4*)(lru_conv_w + 2 * LW + c4) * u1 + *(const f32x4*)(lru_conv_w + 3 * LW + c4) * u0;
                      u32x2 w; w.x = cvt_pk_bf16(v[0], v[1]); w.y = cvt_pk_bf16(v[2], v[3]);
                      *(u32x2*)(VV + row * LW + c4) = w;
                  }
              } }
            asm volatile("s_waitcnt vmcnt(0)" ::: "memory"); __syncthreads();
        }
        { pg8::Gemm g{DD, WT_POOL, PW, 256, 1}; pg8::StaticOrder S; S.init(M, PW, NWG, (int)blockIdx.x);
          EpiPool E{pool_scale, YCAT}; pg8::gemm_phase(lds, g, S, E); }
        { pg8::Gemm g{VV, WT_GATE, LW, 256, 2}; pg8::StaticOrder S; S.init(M, 2 * LW, NWG, (int)blockIdx.x);
          EpiLru E{VV, b_a, b_i, SP8, (unsigned*)AF}; pg8::gemm_phase(lds, g, S, E); }
    }
    xcd_barrier(xbar);

    PH(4) REPS(4)
    { IDS();
        const int c2 = gtid & 1023, chunk = (gtid >> 10) & (NCH - 1), b = gtid >> 16;
        const size_t r0 = (size_t)b * SEQ + (size_t)chunk * CH_L;
        const u32x2* pab = (const u32x2*)((const unsigned*)AF + r0 * LW) + c2;
        f32x2 P = (f32x2){1.f, 1.f}, H = (f32x2){0.f, 0.f};
#pragma unroll 32
        for (int i = 0; i < CH_L; ++i) { const u32x2 q = pab[(size_t)i * (LW / 2)];
            const f32x2 av = (f32x2){__builtin_amdgcn_exp2f(bf_lo(q.x)), __builtin_amdgcn_exp2f(bf_lo(q.y))}, bv = (f32x2){bf_hi(q.x), bf_hi(q.y)}; P = P * av; H = av * H + bv; }
        ((f32x2*)(AGGP + (size_t)(b * NCH + chunk) * LW))[c2] = P; ((f32x2*)(AGGH + (size_t)(b * NCH + chunk) * LW))[c2] = H;
    }
    xcd_barrier(xbar);

    PH(5) REPS(5)
    { IDS();
        const int c2 = gtid & 1023, chunk = (gtid >> 10) & (NCH - 1), b = gtid >> 16;
        f32x2 H = (f32x2){0.f, 0.f};
#pragma unroll 4
        for (int j = 0; j < chunk; ++j) { const f32x2 P = ((const f32x2*)(AGGP + (size_t)(b * NCH + j) * LW))[c2], Hj = ((const f32x2*)(AGGH + (size_t)(b * NCH + j) * LW))[c2]; H = P * H + Hj; }
        const size_t r0 = (size_t)b * SEQ + (size_t)chunk * CH_L;
        const u32x2* pab = (const u32x2*)((const unsigned*)AF + r0 * LW) + c2;
        const unsigned* pg = (const unsigned*)(GELU_U + r0 * LW) + c2; unsigned* po = (unsigned*)(YCAT + r0 * KC + PW) + c2;
#pragma unroll 16
        for (int i = 0; i < CH_L; ++i) {
            const u32x2 q = pab[(size_t)i * (LW / 2)]; const f32x2 av = (f32x2){__builtin_amdgcn_exp2f(bf_lo(q.x)), __builtin_amdgcn_exp2f(bf_lo(q.y))}, bv = (f32x2){bf_hi(q.x), bf_hi(q.y)}; const unsigned gq = pg[(size_t)i * (LW / 2)];
            H = av * H + bv;
            po[(size_t)i * (KC / 2)] = cvt_pk_bf16(H.x * bf_lo(gq), H.y * bf_hi(gq));
        }
    }
    xcd_barrier(xbar);

    PH(6) REPS(6)
    {
        pg8::StaticOrder S; S.init(M, D, NWG, (int)blockIdx.x);
        { pg8::Gemm g{YCAT, WT_CAT, KC, KC, 0}; EpiMerge E{(const unsigned char*)GATES, MERGED}; pg8::gemm_phase(lds, g, S, E); }
    }
    xcd_barrier(xbar);

    PH(7) REPS(7)
    { IDS();
        { pg8::Gemm g{MERGED, WT_OUT, D, D, 0}; pg8::StaticOrder S; S.init(M, D, NWG, (int)blockIdx.x);
          EpiResid1 E{x, X1B, SS2}; pg8::gemm_phase(lds, g, S, E); }
        constexpr int I_UP = (D / 64) * (2 * FF / 32), I_DOWN = (FF / 64) * (D / 32);
        for (int rep2_ = 0; rep2_ < 1 + ((REP_MASK >> 12) & 1); ++rep2_)
        for (int it = gw; it < I_UP + I_DOWN; it += NWV) {
            if (it < I_UP) {
                const int nblk = 2 * FF / 32, kb = it / nblk, nb = it % nblk, n0 = nb * 32, pn = n0 >> 8, bj = (n0 >> 7) & 1, j0 = n0 & 127, k0 = kb * 64;
                tr_tile(w_up + (size_t)k0 * (2 * FF) + bj * FF + pn * 128 + j0, 2 * FF, g_mlp + k0, WT_UP + (size_t)n0 * D + k0, D, scr, lane);
            } else tr_plain(w_down, FF, D, nullptr, WT_DOWN, it - I_UP, scr, lane);
        }
    }
    xcd_barrier(xbar);

    PH(8) REPS(8)
    {
        pg8::Gemm g{X1B, WT_UP, D, D, 0}; pg8::Order2D S; S.init(M, 2 * FF, (int)blockIdx.x);
        EpiUp E{SS2, ffn_conv_w, ffn_conv_b, ACT, TAILG, HEADG, HEADV}; pg8::gemm_phase(lds, g, S, E);
    }
    xcd_barrier(xbar);

    PH(9) REPS(9)
    { IDS();
        for (int idx = gtid; idx < 256 * 2 * (FF / 4); idx += NT) {
            const int f4 = (idx % (FF / 4)) * 4, rr = (idx / (FF / 4)) & 1, blk = idx / (2 * (FF / 4));
            const bool seq0 = (blk & 127) == 0; const size_t row = (size_t)blk * 64 + rr;
            const f32x4 z = (f32x4){0.f, 0.f, 0.f, 0.f};
            const f32x4 gc = *(const f32x4*)(HEADG + ((size_t)blk * 2 + rr) * FF + f4), vv = *(const f32x4*)(HEADV + ((size_t)blk * 2 + rr) * FF + f4);
            f32x4 p1, p2;
            if (rr == 0) { p1 = seq0 ? z : *(const f32x4*)(TAILG + ((size_t)(blk - 1) * 2 + 1) * FF + f4); p2 = seq0 ? z : *(const f32x4*)(TAILG + ((size_t)(blk - 1) * 2 + 0) * FF + f4); }
            else { p1 = *(const f32x4*)(HEADG + ((size_t)blk * 2 + 0) * FF + f4); p2 = seq0 ? z : *(const f32x4*)(TAILG + ((size_t)(blk - 1) * 2 + 1) * FF + f4); }
            const f32x4 cv = *(const f32x4*)(ffn_conv_b + f4) + *(const f32x4*)(ffn_conv_w + f4) * p2 + *(const f32x4*)(ffn_conv_w + FF + f4) * p1 + *(const f32x4*)(ffn_conv_w + 2 * FF + f4) * gc;
            u32x2 w; w.x = cvt_pk_bf16(gelu_tanh(cv[0]) * vv[0], gelu_tanh(cv[1]) * vv[1]); w.y = cvt_pk_bf16(gelu_tanh(cv[2]) * vv[2], gelu_tanh(cv[3]) * vv[3]);
            *(u32x2*)(ACT + row * FF + f4) = w;
        }
    }
    xcd_barrier(xbar);

    PH(10) REPS(10)
    {
        pg8::Gemm g{ACT, WT_DOWN, FF, FF, 0}; pg8::PanelOrder S{(int)blockIdx.x};
        EpiFinal E{X1B, SS3, PCNT, g_final, out}; pg8::gemm_phase(lds, g, S, E);
    }
}

extern "C" void kernel_launch(void* const* d_in, const int* in_sizes, int n_in, void* d_out, int out_size, void* d_ws, size_t ws_size, hipStream_t stream) {
    static int grid = 0;
    if (grid == 0) {
        if (n_in != 22 || in_sizes[0] != M * D || out_size != M * D || ws_size < WS_END) {
            fprintf(stderr, "kernel_launch: unexpected shapes: n_in %d in0 %d out %d ws %zu (need >= %zu)\n", n_in, n_in > 0 ? in_sizes[0] : -1, out_size, ws_size, (size_t)WS_END); grid = -1; return; }
        int dev = 0, cus = 0, per_cu = 0;
        hipGetDevice(&dev); hipDeviceGetAttribute(&cus, hipDeviceAttributeMultiprocessorCount, dev);
        if (hipFuncSetAttribute((const void*)hybrid_block_fwd, hipFuncAttributeMaxDynamicSharedMemorySize, LDS_BYTES) != hipSuccess) { fprintf(stderr, "kernel_launch: hipFuncSetAttribute failed\n"); grid = -1; return; }
        hipOccupancyMaxActiveBlocksPerMultiprocessor(&per_cu, (const void*)hybrid_block_fwd, NTHR, LDS_BYTES);
        (void)hipGetLastError();
        if (cus != NWG || per_cu < 1) fprintf(stderr, "kernel_launch: note: cus %d per_cu %d (kernel is built for a 256-workgroup grid)\n", cus, per_cu);
        grid = NWG;
    }
    if (grid < 0) return;
    if (hipMemsetAsync((char*)d_ws + WS_BAR, 0, (WS_CNT - WS_BAR) + 256, stream) != hipSuccess) { fprintf(stderr, "kernel_launch: hipMemsetAsync failed\n"); return; }
    Args a{};
    for (int i = 0; i < 22; ++i) a.in[i] = (const float*)d_in[i];
    a.out = (float*)d_out; a.ws = (unsigned char*)d_ws;
    void* args[] = {&a};
    hipError_t e = hipLaunchCooperativeKernel((const void*)hybrid_block_fwd, dim3(grid), dim3(NTHR), args, LDS_BYTES, stream);
    if (e != hipSuccess) fprintf(stderr, "kernel_launch: cooperative launch failed: %s\n", hipGetErrorString(e));
}
```

```cpp
#include <hip/hip_runtime.h>
#include <hip/hip_cooperative_groups.h>
#include <cstdio>
#include <cstdint>
namespace cg = cooperative_groups;

#define LAS __attribute__((address_space(3)))
typedef unsigned short bf16_t;
typedef short bf16x8 __attribute__((ext_vector_type(8)));
typedef float f32x4 __attribute__((ext_vector_type(4)));
typedef float f32x2 __attribute__((ext_vector_type(2)));
typedef unsigned u32x4 __attribute__((ext_vector_type(4)));
typedef unsigned u32x2 __attribute__((ext_vector_type(2)));

constexpr int M = 16384, SEQ = 8192, D = 2048, PW = 1024, LW = 2048, INW = 9216, FF = 6144, KC = PW + LW;
constexpr float EPS = 1e-6f;
constexpr int NWG = 256, NTHR = 512, NT = NWG * NTHR, NWV = NT / 64;
constexpr int CH_L = 128, NCH = SEQ / CH_L;

constexpr size_t MiB = 1u << 20;
constexpr size_t WS_RSTD1 = 0, WS_SS2 = 64 * 1024, WS_SS3 = 128 * 1024, WS_SP8 = 192 * 1024;
constexpr size_t WS_BAR = 256 * 1024;
constexpr size_t WS_CNT = 320 * 1024;
constexpr size_t WS_AGGP = 1 * MiB, WS_AGGH = 2 * MiB;
constexpr size_t WS_WT_POOL = 4 * MiB;
constexpr size_t WS_WT_GATE = WS_WT_POOL + MiB / 2;
constexpr size_t WS_WT_PP = WS_WT_GATE + 2 * MiB;
constexpr size_t WS_WT_LP = WS_WT_PP + 4 * MiB;
constexpr size_t WS_WT_OUT = WS_WT_LP + 8 * MiB;
constexpr size_t WS_XB = 27 * MiB;
constexpr size_t WS_WT_IN = 91 * MiB;
constexpr size_t WS_DD = 91 * MiB;
constexpr size_t WS_V = 59 * MiB;
constexpr size_t WS_YLRU = 59 * MiB;
constexpr size_t WS_UPOOL = 127 * MiB;
constexpr size_t WS_YPOOL = 127 * MiB;
constexpr size_t WS_GELU = 159 * MiB;
constexpr size_t WS_X1B = 159 * MiB;
constexpr size_t WS_GATES = 223 * MiB;
constexpr size_t WS_WT_UP = 223 * MiB;
constexpr size_t WS_WT_DOWN = 271 * MiB;
constexpr size_t WS_ULRU = 351 * MiB;
constexpr size_t WS_BX = 351 * MiB;
constexpr size_t WS_V2 = 287 * MiB;
constexpr size_t WS_HEADU = 447 * MiB, WS_TAILU = 453 * MiB;
constexpr size_t WS_YCAT = 351 * MiB;
constexpr size_t WS_MERGED = 447 * MiB;
constexpr size_t WS_ACT = 295 * MiB;
constexpr size_t WS_TAILG = 27 * MiB, WS_HEADG = 39 * MiB, WS_HEADV = 51 * MiB;
constexpr size_t WS_END = 511 * MiB;

constexpr int LDS_BYTES = 131072 + 4096;

__device__ __forceinline__ unsigned cvt_pk_bf16(float lo, float hi) { unsigned r; asm volatile("v_cvt_pk_bf16_f32 %0, %1, %2" : "=v"(r) : "v"(lo), "v"(hi)); return r; }
__device__ __forceinline__ float bf_lo(unsigned w) { return __uint_as_float(w << 16); }
__device__ __forceinline__ float bf_hi(unsigned w) { return __uint_as_float(w & 0xffff0000u); }
__device__ __forceinline__ float sigmoidf_(float x) { return __builtin_amdgcn_rcpf(1.0f + __builtin_amdgcn_exp2f(-1.4426950409f * x)); }
__device__ __forceinline__ float gelu_tanh(float x) {
    const float u = x * (1.5957691216f + 0.0713548163f * x * x);
    return x * __builtin_amdgcn_rcpf(1.0f + __builtin_amdgcn_exp2f(-1.4426950409f * u));
}
__device__ __forceinline__ f32x4 gelu4(f32x4 x) {
    const f32x4 u = x * (x * x * (-0.10294324f) + (-2.3022082f));
    f32x4 e;
#pragma unroll
    for (int j = 0; j < 4; ++j) e[j] = __builtin_amdgcn_exp2f(u[j]);
    const f32x4 d = e + 1.0f; f32x4 r;
#pragma unroll
    for (int j = 0; j < 4; ++j) r[j] = __builtin_amdgcn_rcpf(d[j]);
    return x * r;
}
__device__ __forceinline__ f32x4 sigmoid4(f32x4 x) {
    const f32x4 u = x * (-1.4426950409f); f32x4 e;
#pragma unroll
    for (int j = 0; j < 4; ++j) e[j] = __builtin_amdgcn_exp2f(u[j]);
    const f32x4 d = e + 1.0f; f32x4 r;
#pragma unroll
    for (int j = 0; j < 4; ++j) r[j] = __builtin_amdgcn_rcpf(d[j]);
    return r;
}
__device__ __forceinline__ float wave_sum(float v) {
#pragma unroll
    for (int o = 1; o < 64; o <<= 1) v += __shfl_xor(v, o);
    return v;
}
#define LDS_WAIT() asm volatile("s_waitcnt lgkmcnt(0)" ::: "memory")


#define XB_TMO      128
#define XB_XCNT(j)  (256  + 64 * (j))
#define XB_XSUB(j)  (1280 + 64 * (j))
#define XB_XGEN(j)  (2304 + 64 * (j))
#define XB_TOP      3328
#define XB_TOPGEN   3392
#define XCD_BAR_WORDS 3456
#define XB_SPIN_CAP (1u << 20)
__device__ __forceinline__ unsigned xb_ld(unsigned* p)              { return __hip_atomic_load(p, __ATOMIC_RELAXED, __HIP_MEMORY_SCOPE_AGENT); }
__device__ __forceinline__ unsigned xb_add(unsigned* p, unsigned v) { return __hip_atomic_fetch_add(p, v, __ATOMIC_RELAXED, __HIP_MEMORY_SCOPE_AGENT); }
__device__ __forceinline__ unsigned xb_xcc_id() { return (unsigned)__builtin_amdgcn_s_getreg((3 << 11) | 20) & 0xFu; }
#define XB_SPIN(cond, bar) do { unsigned _sp = 0; while (cond) { __builtin_amdgcn_s_sleep(1); \
    if ((++_sp & 255u) == 0u) { if (xb_ld(&(bar)[XB_TMO])) break; if (_sp > XB_SPIN_CAP) { atomicAdd(&(bar)[XB_TMO], 1u); break; } } } } while (0)
struct XcdBarrier { unsigned* bar; unsigned x; volatile LAS unsigned* st; };
__device__ __forceinline__ XcdBarrier xcd_barrier_post(unsigned* bar, volatile LAS unsigned* st) {
    XcdBarrier b; b.bar = bar; b.x = xb_xcc_id(); b.st = st;
    if (threadIdx.x == 0) (void)xb_add(&bar[XB_XCNT(b.x)], 1u);
    return b;
}
__device__ __forceinline__ void xcd_barrier_complete(unsigned* bar, unsigned x, unsigned& nloc, unsigned& nx) {
    const unsigned G = gridDim.x * gridDim.y * gridDim.z;
    unsigned sum, cnt, mine, sp = 0u;
    for (;;) {
        sum = 0u; cnt = 0u; mine = 0u;
#pragma unroll
        for (unsigned j = 0; j < 16; ++j) { const unsigned c = xb_ld(&bar[XB_XCNT(j)]); sum += c; cnt += (c > 0u) ? 1u : 0u; mine = (j == x) ? c : mine; }
        if (sum == G) break;
        __builtin_amdgcn_s_sleep(1);
        if ((++sp & 255u) == 0u) { if (xb_ld(&bar[XB_TMO])) break; if (sp > XB_SPIN_CAP) { atomicAdd(&bar[XB_TMO], 1u); break; } }
    }
    nloc = mine > 0u ? mine : 1u; nx = cnt > 0u ? cnt : 1u;
}
__device__ __forceinline__ void xcd_barrier(const XcdBarrier& b) {
    asm volatile("s_waitcnt vmcnt(0)" ::: "memory");
    __syncthreads();
    if (threadIdx.x == 0) {
        unsigned* bar = b.bar;
        __builtin_amdgcn_s_waitcnt(0);
        unsigned nloc = b.st[0], nx = b.st[1];
        if (nloc == 0u) { xcd_barrier_complete(bar, b.x, nloc, nx); b.st[0] = nloc; b.st[1] = nx; }
        const unsigned old = xb_add(&bar[XB_XSUB(b.x)], 1u);
        const unsigned gen = old / nloc;
        if (old + 1u == (gen + 1u) * nloc) {
            __builtin_amdgcn_fence(__ATOMIC_RELEASE, "agent");
            asm volatile("s_waitcnt vmcnt(0)" ::: "memory");
            const unsigned og = xb_add(&bar[XB_TOP], 1u);
            const unsigned tg = og / nx;
            if (og + 1u == (tg + 1u) * nx) xb_add(&bar[XB_TOPGEN], 1u);
            else XB_SPIN(xb_ld(&bar[XB_TOPGEN]) == tg, bar);
            __builtin_amdgcn_fence(__ATOMIC_ACQUIRE, "agent");
            xb_add(&bar[XB_XGEN(b.x)], 1u);
            asm volatile("s_waitcnt vmcnt(0)" ::: "memory");
        } else {
            XB_SPIN(xb_ld(&bar[XB_XGEN(b.x)]) == gen, bar);
            __builtin_amdgcn_fence(__ATOMIC_ACQUIRE, "agent");
            asm volatile("s_waitcnt vmcnt(0)" ::: "memory");
        }
    }
    __syncthreads();
}

namespace pg8 {
constexpr int BM = 256, BK = 64, HALF = 128, HTB = HALF * BK * 2, STAGE_BYTES = 8 * HTB, NXCD = 8, WGM = 2;
__host__ __device__ __forceinline__ int lds_byte(int r, int c) { const int st = (r >> 4) * 2 + (c >> 5), rr = r & 15, cc = c & 31, ob = rr * 64 + cc * 2; return st * 1024 + (ob ^ (((ob >> 9) & 1) << 5)); }
__host__ __device__ __forceinline__ void stage_rc(int b, int& R, int& C) { const int st = b / 1024, sb = b % 1024, swz = sb ^ (((sb >> 9) & 1) << 5); R = (st >> 1) * 16 + swz / 64; C = (st & 1) * 32 + (swz % 64) / 2; }
__host__ __device__ __forceinline__ int perm32(int rho) { const int n = rho >> 4, i = rho & 15; return 8 * (i >> 2) + 4 * n + (i & 3); }

struct Unit { int pm, pn; };
struct Gemm { const bf16_t* A; const bf16_t* Bt; int lda, K, agrp; };

struct StaticOrder {
    int nM, nN, nwg, G, c;
    __device__ void init(int M_, int N_, int G_, int c_) { nM = M_ / BM; nN = N_ / BM; nwg = nM * nN; G = G_; c = c_; }
    __device__ bool next(int i, Unit& u) const {
        const long L = (long)i * G + c; if (L >= nwg) return false;
        int wgid = (int)L; { const int q = nwg / NXCD, r = nwg % NXCD, xcd = wgid % NXCD, off = wgid / NXCD; wgid = (xcd < r ? xcd * (q + 1) : r * (q + 1) + (xcd - r) * q) + off; }
        const int nig = WGM * nN, gid = wgid / nig, fm = gid * WGM, gsz = (nM - fm) < WGM ? (nM - fm) : WGM;
        u.pm = fm + ((wgid % nig) % gsz); u.pn = (wgid % nig) / gsz; return true;
    }
};

struct Order2D {
    int c, nbn, nrounds, tail;
    __device__ void init(int M_, int N_, int c_) { c = c_; nbn = (N_ / BM) / 16; nrounds = ((M_ / BM) / 16) * nbn; tail = ((N_ / BM) % 16) ? 1 : 0; }
    __device__ bool next(int i, Unit& u) const {
        const int x = c & 7, j = c >> 3;
        if (i >= nrounds) { if (i >= nrounds + tail) return false; u.pm = 8 * x + (j & 7); u.pn = 16 * nbn + (j >> 3); return true; }
        const int xr = x & 3, xc = x >> 2, bm = i / nbn, bn = i % nbn;
        u.pm = 16 * bm + 4 * xr + (j & 3); u.pn = 16 * bn + 8 * xc + (j >> 2); return true;
    }
};
struct PanelOrder {
    int c;
    __device__ bool next(int i, Unit& u) const { if (i >= 2) return false; const int x = c & 7, j = c >> 3; u.pm = 8 * x + (j >> 3) + 4 * i; u.pn = j & 7; return true; }
};

template <class Epi, class Sched>
__device__ __forceinline__ void gemm_phase(LAS unsigned char* lds, const Gemm g, const Sched& S, const Epi& E) {
    int tid = threadIdx.x; asm volatile("" : "+v"(tid));
    const int wid = __builtin_amdgcn_readfirstlane(tid >> 6), lane = tid & 63, wr = wid >> 2, wc = wid & 3, fr = lane & 15, fq = lane >> 4;
    const int K = g.K, nt = K / BK, lda = g.lda;
    unsigned voffA[2], voffB[2];
#pragma unroll
    for (int i = 0; i < 2; ++i) { int R, C; stage_rc(tid * 16 + i * 8192, R, C); const int Rb = (R & ~31) + perm32(R & 31);
        voffA[i] = (unsigned)(R * lda + C) * 2u; voffB[i] = (unsigned)(Rb * K + C) * 2u; }
    const size_t kstep = (size_t)(BK * 2);
    const size_t hstepA = (size_t)HALF * lda * 2, tstepA = 2 * hstepA;
    const size_t hstepB = (size_t)HALF * K * 2, tstepB = 2 * hstepB;
    const unsigned ldsw = (unsigned)wid * 1024u;
    const int aoff = lds_byte(wr * 64 + fr, fq * 8), boff = lds_byte(wc * 32 + fr, fq * 8);
#define PG8_SA(b, h) (((b) * 2 + (h)) * HTB)
#define PG8_SB(b, h) ((4 + (b) * 2 + (h)) * HTB)
#define PG8_STAGE(bufoff, gbase, voff) do { _Pragma("unroll") for (int _i = 0; _i < 2; ++_i) \
        __builtin_amdgcn_global_load_lds((const unsigned*)((const char*)(gbase) + (voff)[_i]), (LAS unsigned*)(lds + (bufoff) + ldsw + _i * 8192), 16, 0, 0); } while (0)
#define PG8_LDA(dst, b, h) do { _Pragma("unroll") for (int m = 0; m < 4; ++m) _Pragma("unroll") for (int k = 0; k < 2; ++k) dst[m][k] = *(const LAS bf16x8*)(lds + PG8_SA(b, h) + aoff + m * 2048 + k * 1024); } while (0)
#define PG8_LDB(dst, b, h) do { _Pragma("unroll") for (int n = 0; n < 2; ++n) _Pragma("unroll") for (int k = 0; k < 2; ++k) dst[n][k] = *(const LAS bf16x8*)(lds + PG8_SB(b, h) + boff + n * 2048 + k * 1024); } while (0)
#define PG8_MMA(ai, bj, At, Bt) do { __builtin_amdgcn_s_setprio(1); _Pragma("unroll") for (int m = 0; m < 4; ++m) _Pragma("unroll") for (int n = 0; n < 2; ++n) _Pragma("unroll") for (int k = 0; k < 2; ++k) \
        acc[ai][bj][m][n] = __builtin_amdgcn_mfma_f32_16x16x32_bf16(Bt[n][k], At[m][k], acc[ai][bj][m][n], 0, 0, 0); __builtin_amdgcn_s_setprio(0); } while (0)
#define PG8_WAIT_V(n) asm volatile("s_waitcnt vmcnt(" #n ")" ::: "memory")
#define PG8_WAIT_L(n) asm volatile("s_waitcnt lgkmcnt(" #n ")" ::: "memory")
#define PG8_BAR __builtin_amdgcn_s_barrier()
#define PG8_SCHED __builtin_amdgcn_sched_barrier(0)
#define PG8_ABASE(u) ((const char*)g.A + (size_t)(u).pm * tstepA + (g.agrp ? (size_t)((u).pn / g.agrp) * 512 : (size_t)0))
#define PG8_BBASE(u) ((const char*)g.Bt + (size_t)(u).pn * tstepB)
    Unit cur, nxt; int ui = 0;
    if (!S.next(0, cur)) return;
    f32x4 acc[2][2][4][2];
#pragma unroll
    for (int a = 0; a < 2; ++a)
#pragma unroll
        for (int b = 0; b < 2; ++b)
#pragma unroll
            for (int m = 0; m < 4; ++m)
#pragma unroll
                for (int n = 0; n < 2; ++n) acc[a][b][m][n] = (f32x4){0.f, 0.f, 0.f, 0.f};
    bf16x8 At[4][2], B0[2][2], B1[2][2];
    const char* cA = PG8_ABASE(cur); const char* cB = PG8_BBASE(cur);
    PG8_STAGE(PG8_SB(0, 0), cB, voffB); PG8_STAGE(PG8_SB(0, 1), cB + hstepB, voffB); PG8_STAGE(PG8_SA(0, 0), cA, voffA); PG8_STAGE(PG8_SA(0, 1), cA + hstepA, voffA);
    if (wr == 1) PG8_BAR;
    PG8_WAIT_V(2); PG8_BAR;
    PG8_STAGE(PG8_SB(1, 0), cB + kstep, voffB); PG8_STAGE(PG8_SA(1, 0), cA + kstep, voffA); PG8_STAGE(PG8_SB(1, 1), cB + hstepB + kstep, voffB);
    PG8_WAIT_V(6); PG8_BAR;
    for (;;) {
        const bool has_next = S.next(ui + 1, nxt);
        const char* nA = has_next ? PG8_ABASE(nxt) : cA; const char* nB = has_next ? PG8_BBASE(nxt) : cB;
#pragma unroll 1
        for (int t = 0; t < nt; t += 2) {
            if constexpr (Epi::MIDT >= 0) {
                if (t == Epi::MIDT) { int fr_m = fr, fq_m = fq; asm volatile("" : "+v"(fr_m), "+v"(fq_m)); E.mid(acc, cur, wr, wc, fr_m, fq_m); }
            }
            const bool last = (t == nt - 2);
            const char* a1 = cA + (size_t)(t + 1) * kstep;
            const char* a2 = last ? nA : cA + (size_t)(t + 2) * kstep; const char* b2 = last ? nB : cB + (size_t)(t + 2) * kstep;
            const char* a3 = a2 + kstep; const char* b3 = b2 + kstep;
            PG8_LDB(B0, 0, 0); PG8_LDB(B1, 0, 1); PG8_SCHED; PG8_LDA(At, 0, 0); PG8_STAGE(PG8_SA(1, 1), a1 + hstepA, voffA);
            PG8_WAIT_V(8); PG8_WAIT_L(0); PG8_BAR; PG8_MMA(0, 0, At, B0); PG8_MMA(0, 1, At, B1); PG8_BAR; PG8_SCHED;
            PG8_LDA(At, 0, 1); PG8_STAGE(PG8_SB(0, 0), b2, voffB); PG8_STAGE(PG8_SB(0, 1), b2 + hstepB, voffB); PG8_STAGE(PG8_SA(0, 0), a2, voffA);
            PG8_WAIT_V(8); PG8_WAIT_L(0); PG8_BAR; PG8_MMA(1, 0, At, B0); PG8_MMA(1, 1, At, B1); PG8_BAR; PG8_SCHED;
            PG8_LDB(B0, 1, 0); PG8_LDB(B1, 1, 1); PG8_SCHED; PG8_LDA(At, 1, 0); PG8_STAGE(PG8_SA(0, 1), a2 + hstepA, voffA);
            PG8_WAIT_V(8); PG8_WAIT_L(0); PG8_BAR; PG8_MMA(0, 0, At, B0); PG8_MMA(0, 1, At, B1); PG8_BAR; PG8_SCHED;
            PG8_LDA(At, 1, 1); PG8_STAGE(PG8_SB(1, 0), b3, voffB); PG8_STAGE(PG8_SB(1, 1), b3 + hstepB, voffB); PG8_STAGE(PG8_SA(1, 0), a3, voffA);
            PG8_WAIT_V(8); PG8_WAIT_L(0); PG8_BAR; PG8_MMA(1, 0, At, B0); PG8_MMA(1, 1, At, B1); PG8_BAR; PG8_SCHED;
        }
        if (wr == 0) PG8_BAR;
        { int fr_e = fr, fq_e = fq; asm volatile("" : "+v"(fr_e), "+v"(fq_e));
          E(acc, cur, wr, wc, fr_e, fq_e); }
        if (!has_next) break;
#pragma unroll
        for (int a = 0; a < 2; ++a)
#pragma unroll
            for (int b = 0; b < 2; ++b)
#pragma unroll
                for (int m = 0; m < 4; ++m)
#pragma unroll
                    for (int n = 0; n < 2; ++n) acc[a][b][m][n] = (f32x4){0.f, 0.f, 0.f, 0.f};
        cur = nxt; cA = nA; cB = nB; ++ui;
        if (wr == 1) PG8_BAR;
    }
    PG8_WAIT_V(0);
    PG8_BAR;
#undef PG8_SA
#undef PG8_SB
#undef PG8_STAGE
#undef PG8_LDA
#undef PG8_LDB
#undef PG8_MMA
#undef PG8_WAIT_V
#undef PG8_WAIT_L
#undef PG8_BAR
#undef PG8_SCHED
#undef PG8_ABASE
#undef PG8_BBASE
}
}
using pg8::Unit;

#define EPI_ARGS const f32x4 (&acc)[2][2][4][2], const Unit& u, int wr, int wc, int fr, int fq
#define ROW_OF(ai, m) (u.pm * 256 + (ai) * 128 + wr * 64 + (m) * 16 + fr)

struct EpiProj {
    static constexpr int MIDT = -1;
    const float* zeros; const float* b_gate; bf16_t *upool, *ulru, *gelu_u, *gates;
    const float* cw; const float* cb; bf16_t* vout; float* headu; float* tailu;
    __device__ __forceinline__ void operator()(EPI_ARGS) const {
        const int pn = u.pn;
        if (pn >= 4 && pn < 12) {
            const int lane = fq * 16 + fr, s1 = (lane & 48) | ((fr - 1) & 15), s2 = (lane & 48) | ((fr - 2) & 15), s3 = (lane & 48) | ((fr - 3) & 15);
#pragma unroll
            for (int bj = 0; bj < 2; ++bj) {
                const int c0 = (pn - 4) * 256 + bj * 128 + wc * 32 + 8 * fq;
                f32x4 w0[2], w1[2], w2[2], w3[2], bb[2];
#pragma unroll
                for (int n = 0; n < 2; ++n) { w0[n] = *(const f32x4*)(cw + c0 + 4 * n); w1[n] = *(const f32x4*)(cw + LW + c0 + 4 * n); w2[n] = *(const f32x4*)(cw + 2 * LW + c0 + 4 * n); w3[n] = *(const f32x4*)(cw + 3 * LW + c0 + 4 * n); bb[n] = *(const f32x4*)(cb + c0 + 4 * n); }
#pragma unroll
                for (int ai = 0; ai < 2; ++ai) {
                    const int blk = u.pm * 4 + ai * 2 + wr;
                    f32x4 q1[2], q2[2], q3[2];
#pragma unroll
                    for (int n = 0; n < 2; ++n) { q1[n] = (f32x4){0.f, 0.f, 0.f, 0.f}; q2[n] = q1[n]; q3[n] = q1[n]; }
#pragma unroll
                    for (int m = 0; m < 4; ++m) {
                        const int row = ROW_OF(ai, m);
                        f32x4 o[2];
#pragma unroll
                        for (int n = 0; n < 2; ++n) {
                            const f32x4 gv = acc[ai][bj][m][n];
                            f32x4 r1, r2, r3, p1, p2, p3;
#pragma unroll
                            for (int j = 0; j < 4; ++j) { r1[j] = __shfl(gv[j], s1); r2[j] = __shfl(gv[j], s2); r3[j] = __shfl(gv[j], s3); }
#pragma unroll
                            for (int j = 0; j < 4; ++j) { p1[j] = fr >= 1 ? r1[j] : q1[n][j]; p2[j] = fr >= 2 ? r2[j] : q2[n][j]; p3[j] = fr >= 3 ? r3[j] : q3[n][j]; }
                            q1[n] = r1; q2[n] = r2; q3[n] = r3;
                            o[n] = bb[n] + w0[n] * p3 + w1[n] * p2 + w2[n] * p1 + w3[n] * gv;
                            if (m == 0 && fr < 3) *(f32x4*)(headu + ((size_t)blk * 3 + fr) * LW + c0 + 4 * n) = gv;
                            if (m == 3 && fr >= 13) *(f32x4*)(tailu + ((size_t)blk * 3 + (fr - 13)) * LW + c0 + 4 * n) = gv;
                        }
                        if (!(m == 0 && fr < 3)) {
                            u32x4 w; w.x = cvt_pk_bf16(o[0][0], o[0][1]); w.y = cvt_pk_bf16(o[0][2], o[0][3]); w.z = cvt_pk_bf16(o[1][0], o[1][1]); w.w = cvt_pk_bf16(o[1][2], o[1][3]);
                            *(u32x4*)(vout + (size_t)row * LW + c0) = w;
                        }
                    }
                }
            }
            return;
        }
        bf16_t* base; int ldc, colt, mode;
        if (pn < 4) { base = upool; ldc = PW; colt = pn * 256; mode = 0; }
        else if (pn < 12) { base = ulru; ldc = LW; colt = (pn - 4) * 256; mode = 0; }
        else if (pn < 20) { base = gelu_u; ldc = LW; colt = (pn - 12) * 256; mode = 1; }
        else { base = gates; ldc = 2 * D; colt = (pn - 20) * 256; mode = 2; }
        const int col0 = colt + wc * 32 + 8 * fq;
        const float* bsrc = (mode == 2) ? b_gate : zeros;
        f32x4 bv[2][2];
#pragma unroll
        for (int bj = 0; bj < 2; ++bj)
#pragma unroll
            for (int n = 0; n < 2; ++n) bv[bj][n] = *(const f32x4*)(bsrc + col0 + bj * 128 + 4 * n);
#pragma unroll
        for (int ai = 0; ai < 2; ++ai)
#pragma unroll
            for (int m = 0; m < 4; ++m) {
                const int row = ROW_OF(ai, m);
                bf16_t* rowp = base + (size_t)row * ldc + col0;
#pragma unroll
                for (int bj = 0; bj < 2; ++bj) {
                    f32x4 v0 = acc[ai][bj][m][0], v1 = acc[ai][bj][m][1];
                    v0 = v0 + bv[bj][0]; v1 = v1 + bv[bj][1];
                    if (mode == 1) { v0 = gelu4(v0); v1 = gelu4(v1); }
                    else if (mode == 2) { v0 = sigmoid4(v0); v1 = sigmoid4(v1); }
                    if (mode == 2) {
                        v0 = v0 * 255.0f; v1 = v1 * 255.0f; u32x2 w; w.x = 0u; w.y = 0u;
                        w.x = __builtin_amdgcn_cvt_pk_u8_f32(v0[0], 0, w.x); w.x = __builtin_amdgcn_cvt_pk_u8_f32(v0[1], 1, w.x); w.x = __builtin_amdgcn_cvt_pk_u8_f32(v0[2], 2, w.x); w.x = __builtin_amdgcn_cvt_pk_u8_f32(v0[3], 3, w.x);
                        w.y = __builtin_amdgcn_cvt_pk_u8_f32(v1[0], 0, w.y); w.y = __builtin_amdgcn_cvt_pk_u8_f32(v1[1], 1, w.y); w.y = __builtin_amdgcn_cvt_pk_u8_f32(v1[2], 2, w.y); w.y = __builtin_amdgcn_cvt_pk_u8_f32(v1[3], 3, w.y);
                        *(u32x2*)((unsigned char*)gates + (size_t)row * (2 * D) + col0 + bj * 128) = w;
                    } else {
                        u32x4 w; w.x = cvt_pk_bf16(v0[0], v0[1]); w.y = cvt_pk_bf16(v0[2], v0[3]); w.z = cvt_pk_bf16(v1[0], v1[1]); w.w = cvt_pk_bf16(v1[2], v1[3]);
                        *(u32x4*)(rowp + bj * 128) = w;
                    }
                }
            }
    }
};

struct EpiPool {
    static constexpr int MIDT = -1;
    const float* pool_scale; bf16_t* ypool;
    __device__ __forceinline__ void operator()(EPI_ARGS) const {
        const int col0 = u.pn * 256 + wc * 32 + 8 * fq;
        f32x4 sc[2][2];
#pragma unroll
        for (int bj = 0; bj < 2; ++bj)
#pragma unroll
            for (int n = 0; n < 2; ++n) sc[bj][n] = *(const f32x4*)(pool_scale + col0 + bj * 128 + 4 * n);
#pragma unroll
        for (int ai = 0; ai < 2; ++ai)
#pragma unroll
            for (int m = 0; m < 4; ++m) {
                bf16_t* rowp = ypool + (size_t)ROW_OF(ai, m) * KC + col0;
#pragma unroll
                for (int bj = 0; bj < 2; ++bj) {
                    const f32x4 v0 = acc[ai][bj][m][0] * sc[bj][0], v1 = acc[ai][bj][m][1] * sc[bj][1];
                    u32x4 w; w.x = cvt_pk_bf16(v0[0], v0[1]); w.y = cvt_pk_bf16(v0[2], v0[3]); w.z = cvt_pk_bf16(v1[0], v1[1]); w.w = cvt_pk_bf16(v1[2], v1[3]);
                    *(u32x4*)(rowp + bj * 128) = w;
                }
            }
    }
};

struct EpiLru {
    static constexpr int MIDT = -1;
    const bf16_t* V; const float* b_a; const float* b_i; const float* sp8; unsigned* AB;
    __device__ __forceinline__ void operator()(EPI_ARGS) const {
        const int c0 = (u.pn >> 1) * 256 + (u.pn & 1) * 128 + wc * 32 + 8 * fq;
        u32x4 vv[2][4];
#pragma unroll
        for (int ai = 0; ai < 2; ++ai)
#pragma unroll
            for (int m = 0; m < 4; ++m) vv[ai][m] = *(const u32x4*)(V + (size_t)ROW_OF(ai, m) * LW + c0);
        f32x4 ba[2], bi[2], sp[2];
#pragma unroll
        for (int n = 0; n < 2; ++n) { ba[n] = *(const f32x4*)(b_a + c0 + 4 * n); bi[n] = *(const f32x4*)(b_i + c0 + 4 * n); sp[n] = *(const f32x4*)(sp8 + c0 + 4 * n); }
#pragma unroll
        for (int ai = 0; ai < 2; ++ai)
#pragma unroll
            for (int m = 0; m < 4; ++m) {
                const int row = ROW_OF(ai, m);
#pragma unroll
                for (int n = 0; n < 2; ++n) {
                    const unsigned w0 = n ? vv[ai][m].z : vv[ai][m].x, w1 = n ? vv[ai][m].w : vv[ai][m].y;
                    const f32x4 vx = (f32x4){bf_lo(w0), bf_hi(w0), bf_lo(w1), bf_hi(w1)};
                    const f32x4 r = sigmoid4(acc[ai][0][m][n] + ba[n]), ig = sigmoid4(acc[ai][1][m][n] + bi[n]);
                    const f32x4 la = sp[n] * r * (-1.4426950409f);
                    f32x4 av;
#pragma unroll
                    for (int j = 0; j < 4; ++j) av[j] = __builtin_amdgcn_exp2f(la[j]);
                    const f32x4 om = 1.0f - av * av; f32x4 sq;
#pragma unroll
                    for (int j = 0; j < 4; ++j) sq[j] = __builtin_amdgcn_sqrtf(om[j]);
                    const f32x4 bx = sq * ig * vx;
                    u32x4 w; w.x = cvt_pk_bf16(la[0], bx[0]); w.y = cvt_pk_bf16(la[1], bx[1]); w.z = cvt_pk_bf16(la[2], bx[2]); w.w = cvt_pk_bf16(la[3], bx[3]);
                    *(u32x4*)(AB + (size_t)row * LW + c0 + 4 * n) = w;
                }
            }
    }
};

#define UNPKG(q, lo, hi) const f32x4 lo = (f32x4){(float)((q).x & 0xff), (float)(((q).x >> 8) & 0xff), (float)(((q).x >> 16) & 0xff), (float)((q).x >> 24)} * (1.0f / 255.0f), hi = (f32x4){(float)((q).y & 0xff), (float)(((q).y >> 8) & 0xff), (float)(((q).y >> 16) & 0xff), (float)((q).y >> 24)} * (1.0f / 255.0f)
#define UNPK4(q, lo, hi) const f32x4 lo = (f32x4){bf_lo((q).x), bf_hi((q).x), bf_lo((q).y), bf_hi((q).y)}, hi = (f32x4){bf_lo((q).z), bf_hi((q).z), bf_lo((q).w), bf_hi((q).w)}
struct EpiMerge {
    static constexpr int MIDT = PW / 64;
    const unsigned char* gates; bf16_t* merged;
    __device__ __forceinline__ void mid(f32x4 (&acc)[2][2][4][2], const Unit& u, int wr, int wc, int fr, int fq) const {
        const int col0 = u.pn * 256 + wc * 32 + 8 * fq;
        u32x2 ac[2], bc[2], an[2], bn[2];
#pragma unroll
        for (int bj = 0; bj < 2; ++bj) { const unsigned char* p = gates + (size_t)ROW_OF(0, 0) * (2 * D) + col0 + bj * 128; ac[bj] = *(const u32x2*)p; bc[bj] = *(const u32x2*)(p + D); }
#pragma unroll
        for (int g = 0; g < 8; ++g) {
            const int ai = g >> 2, m = g & 3;
            if (g < 7) {
#pragma unroll
                for (int bj = 0; bj < 2; ++bj) { const unsigned char* p = gates + (size_t)ROW_OF((g + 1) >> 2, (g + 1) & 3) * (2 * D) + col0 + bj * 128; an[bj] = *(const u32x2*)p; bn[bj] = *(const u32x2*)(p + D); }
            }
#pragma unroll
            for (int bj = 0; bj < 2; ++bj) {
                const unsigned a0 = ac[bj].x, a1 = ac[bj].y, b0 = bc[bj].x, b1 = bc[bj].y;
                f32x4 r0, r1;
#pragma unroll
                for (int j = 0; j < 4; ++j) {
                    r0[j] = (float)((a0 >> (8 * j)) & 0xff) * __builtin_amdgcn_rcpf(fmaxf((float)((b0 >> (8 * j)) & 0xff), 0.5f));
                    r1[j] = (float)((a1 >> (8 * j)) & 0xff) * __builtin_amdgcn_rcpf(fmaxf((float)((b1 >> (8 * j)) & 0xff), 0.5f));
                }
                acc[ai][bj][m][0] = acc[ai][bj][m][0] * r0; acc[ai][bj][m][1] = acc[ai][bj][m][1] * r1;
            }
            if (g < 7) { ac[0] = an[0]; ac[1] = an[1]; bc[0] = bn[0]; bc[1] = bn[1]; }
        }
    }
    __device__ __forceinline__ void operator()(EPI_ARGS) const {
        const int col0 = u.pn * 256 + wc * 32 + 8 * fq;
        u32x2 gc[2], gn[2];
#pragma unroll
        for (int bj = 0; bj < 2; ++bj) gc[bj] = *(const u32x2*)(gates + (size_t)ROW_OF(0, 0) * (2 * D) + D + col0 + bj * 128);
#pragma unroll
        for (int g = 0; g < 8; ++g) {
            const int ai = g >> 2, m = g & 3, row = ROW_OF(ai, m);
            if (g < 7) {
#pragma unroll
                for (int bj = 0; bj < 2; ++bj) gn[bj] = *(const u32x2*)(gates + (size_t)ROW_OF((g + 1) >> 2, (g + 1) & 3) * (2 * D) + D + col0 + bj * 128);
            }
#pragma unroll
            for (int bj = 0; bj < 2; ++bj) {
                const unsigned b0 = gc[bj].x, b1 = gc[bj].y;
                f32x4 g0, g1;
#pragma unroll
                for (int j = 0; j < 4; ++j) { g0[j] = fmaxf((float)((b0 >> (8 * j)) & 0xff), 0.5f) * (1.0f / 255.0f); g1[j] = fmaxf((float)((b1 >> (8 * j)) & 0xff), 0.5f) * (1.0f / 255.0f); }
                const f32x4 v0 = acc[ai][bj][m][0] * g0, v1 = acc[ai][bj][m][1] * g1;
                u32x4 w; w.x = cvt_pk_bf16(v0[0], v0[1]); w.y = cvt_pk_bf16(v0[2], v0[3]); w.z = cvt_pk_bf16(v1[0], v1[1]); w.w = cvt_pk_bf16(v1[2], v1[3]);
                *(u32x4*)(merged + (size_t)row * D + col0 + bj * 128) = w;
            }
            if (g < 7) { gc[0] = gn[0]; gc[1] = gn[1]; }
        }
    }
};

struct EpiResid1 {
    static constexpr int MIDT = -1;
    const bf16_t* xn; const float* nrm; bf16_t* xb; float* ss;
    __device__ __forceinline__ void operator()(EPI_ARGS) const {
        const int col0 = u.pn * 256 + wc * 32 + 8 * fq;
        float nr[8];
#pragma unroll
        for (int g = 0; g < 8; ++g) nr[g] = nrm[ROW_OF(g >> 2, g & 3)];
        u32x4 xc[2], xq[2];
#pragma unroll
        for (int bj = 0; bj < 2; ++bj) xc[bj] = *(const u32x4*)(xn + (size_t)ROW_OF(0, 0) * D + col0 + bj * 128);
#pragma unroll
        for (int g = 0; g < 8; ++g) {
            const int ai = g >> 2, m = g & 3, row = ROW_OF(ai, m); float s = 0.f;
            if (g < 7) {
#pragma unroll
                for (int bj = 0; bj < 2; ++bj) xq[bj] = *(const u32x4*)(xn + (size_t)ROW_OF((g + 1) >> 2, (g + 1) & 3) * D + col0 + bj * 128);
            }
#pragma unroll
            for (int bj = 0; bj < 2; ++bj) {
                const size_t off = (size_t)row * D + col0 + bj * 128;
                UNPK4(xc[bj], x0, x1);
                const f32x4 v0 = x0 * nr[g] + acc[ai][bj][m][0], v1 = x1 * nr[g] + acc[ai][bj][m][1];
                s += (v0[0] * v0[0] + v0[1] * v0[1]) + (v0[2] * v0[2] + v0[3] * v0[3]) + (v1[0] * v1[0] + v1[1] * v1[1]) + (v1[2] * v1[2] + v1[3] * v1[3]);
                u32x4 w; w.x = cvt_pk_bf16(v0[0], v0[1]); w.y = cvt_pk_bf16(v0[2], v0[3]); w.z = cvt_pk_bf16(v1[0], v1[1]); w.w = cvt_pk_bf16(v1[2], v1[3]); *(u32x4*)(xb + off) = w;
            }
            s += __shfl_xor(s, 16); s += __shfl_xor(s, 32);
            if (fq == 0) __hip_atomic_fetch_add(ss + row, s, __ATOMIC_RELAXED, __HIP_MEMORY_SCOPE_AGENT);
            if (g < 7) { xc[0] = xq[0]; xc[1] = xq[1]; }
        }
    }
};
struct EpiResid2 {
    static constexpr int MIDT = -1;
    bf16_t* xb; float* ss;
    __device__ __forceinline__ void operator()(EPI_ARGS) const {
        const int col0 = u.pn * 256 + wc * 32 + 8 * fq;
        u32x4 xc[2], xn[2];
#pragma unroll
        for (int bj = 0; bj < 2; ++bj) xc[bj] = *(const u32x4*)(xb + (size_t)ROW_OF(0, 0) * D + col0 + bj * 128);
#pragma unroll
        for (int g = 0; g < 8; ++g) {
            const int ai = g >> 2, m = g & 3, row = ROW_OF(ai, m); float s = 0.f;
            if (g < 7) {
#pragma unroll
                for (int bj = 0; bj < 2; ++bj) xn[bj] = *(const u32x4*)(xb + (size_t)ROW_OF((g + 1) >> 2, (g + 1) & 3) * D + col0 + bj * 128);
            }
#pragma unroll
            for (int bj = 0; bj < 2; ++bj) {
                UNPK4(xc[bj], x0, x1);
                const f32x4 v0 = x0 + acc[ai][bj][m][0], v1 = x1 + acc[ai][bj][m][1];
                s += (v0[0] * v0[0] + v0[1] * v0[1]) + (v0[2] * v0[2] + v0[3] * v0[3]) + (v1[0] * v1[0] + v1[1] * v1[1]) + (v1[2] * v1[2] + v1[3] * v1[3]);
                u32x4 w; w.x = cvt_pk_bf16(v0[0], v0[1]); w.y = cvt_pk_bf16(v0[2], v0[3]); w.z = cvt_pk_bf16(v1[0], v1[1]); w.w = cvt_pk_bf16(v1[2], v1[3]);
                *(u32x4*)(xb + (size_t)row * D + col0 + bj * 128) = w;
            }
            s += __shfl_xor(s, 16); s += __shfl_xor(s, 32);
            if (fq == 0) __hip_atomic_fetch_add(ss + row, s, __ATOMIC_RELAXED, __HIP_MEMORY_SCOPE_AGENT);
            if (g < 7) { xc[0] = xn[0]; xc[1] = xn[1]; }
        }
    }
};

struct EpiFinal {
    static constexpr int MIDT = -1;
    const bf16_t* xb; float* ss; unsigned* cnt; const float* gfin; float* out;
    __device__ __forceinline__ void operator()(f32x4 (&acc)[2][2][4][2], const Unit& u, int wr, int wc, int fr, int fq) const {
        const int col0 = u.pn * 256 + wc * 32 + 8 * fq;
        u32x4 xc[2], xn[2];
#pragma unroll
        for (int bj = 0; bj < 2; ++bj) xc[bj] = *(const u32x4*)(xb + (size_t)ROW_OF(0, 0) * D + col0 + bj * 128);
#pragma unroll
        for (int g = 0; g < 8; ++g) {
            const int ai = g >> 2, m = g & 3, row = ROW_OF(ai, m); float s = 0.f;
            if (g < 7) {
#pragma unroll
                for (int bj = 0; bj < 2; ++bj) xn[bj] = *(const u32x4*)(xb + (size_t)ROW_OF((g + 1) >> 2, (g + 1) & 3) * D + col0 + bj * 128);
            }
#pragma unroll
            for (int bj = 0; bj < 2; ++bj) {
                UNPK4(xc[bj], x0, x1);
                const f32x4 v0 = x0 + acc[ai][bj][m][0], v1 = x1 + acc[ai][bj][m][1];
                acc[ai][bj][m][0] = v0; acc[ai][bj][m][1] = v1;
                s += (v0[0] * v0[0] + v0[1] * v0[1]) + (v0[2] * v0[2] + v0[3] * v0[3]) + (v1[0] * v1[0] + v1[1] * v1[1]) + (v1[2] * v1[2] + v1[3] * v1[3]);
            }
            s += __shfl_xor(s, 16); s += __shfl_xor(s, 32);
            if (fq == 0) __hip_atomic_fetch_add(ss + row, s, __ATOMIC_RELAXED, __HIP_MEMORY_SCOPE_AGENT);
            if (g < 7) { xc[0] = xn[0]; xc[1] = xn[1]; }
        }
        asm volatile("s_waitcnt vmcnt(0)" ::: "memory"); __builtin_amdgcn_s_barrier();
        if (threadIdx.x == 0) {
            __hip_atomic_fetch_add(cnt + u.pm, 1u, __ATOMIC_RELAXED, __HIP_MEMORY_SCOPE_AGENT);
            unsigned sp = 0;
            while (__hip_atomic_load(cnt + u.pm, __ATOMIC_RELAXED, __HIP_MEMORY_SCOPE_AGENT) < 8u) { __builtin_amdgcn_s_sleep(1); if (++sp > (1u << 22)) break; }
        }
        asm volatile("s_waitcnt vmcnt(0) lgkmcnt(0)" ::: "memory"); __builtin_amdgcn_s_barrier(); asm volatile("" ::: "memory");
        float rs[8];
#pragma unroll
        for (int g = 0; g < 8; ++g) rs[g] = __hip_atomic_load(ss + ROW_OF(g >> 2, g & 3), __ATOMIC_RELAXED, __HIP_MEMORY_SCOPE_AGENT);
        f32x4 gf[2][2];
#pragma unroll
        for (int bj = 0; bj < 2; ++bj) { gf[bj][0] = *(const f32x4*)(gfin + col0 + bj * 128); gf[bj][1] = *(const f32x4*)(gfin + col0 + bj * 128 + 4); }
#pragma unroll
        for (int g = 0; g < 8; ++g) {
            const int ai = g >> 2, m = g & 3, row = ROW_OF(ai, m);
            const float r = 1.0f / sqrtf(rs[g] * (1.0f / D) + EPS);
#pragma unroll
            for (int bj = 0; bj < 2; ++bj) {
                float* op = out + (size_t)row * D + col0 + bj * 128;
                *(f32x4*)(op) = acc[ai][bj][m][0] * r * gf[bj][0]; *(f32x4*)(op + 4) = acc[ai][bj][m][1] * r * gf[bj][1];
            }
        }
    }
};

struct EpiUp {
    static constexpr int MIDT = -1;
    const float* ss2; const float* cw; const float* cb; bf16_t* act; float* tailg; float* headg; float* headv;
    __device__ __forceinline__ void operator()(EPI_ARGS) const {
        const int f0 = u.pn * 128 + wc * 32 + 8 * fq;
        const int lane = fq * 16 + fr, src1 = (lane & 48) | ((fr - 1) & 15), src2 = (lane & 48) | ((fr - 2) & 15);
        f32x4 w0[2], w1[2], w2[2], bb[2];
#pragma unroll
        for (int n = 0; n < 2; ++n) { w0[n] = *(const f32x4*)(cw + f0 + 4 * n); w1[n] = *(const f32x4*)(cw + FF + f0 + 4 * n); w2[n] = *(const f32x4*)(cw + 2 * FF + f0 + 4 * n); bb[n] = *(const f32x4*)(cb + f0 + 4 * n); }
        float rsv[2][4];
#pragma unroll
        for (int ai = 0; ai < 2; ++ai)
#pragma unroll
            for (int m = 0; m < 4; ++m) rsv[ai][m] = ss2[ROW_OF(ai, m)];
#pragma unroll
        for (int ai = 0; ai < 2; ++ai) {
            const int blk = u.pm * 4 + ai * 2 + wr;
            f32x4 q1[2], q2[2];
#pragma unroll
            for (int n = 0; n < 2; ++n) { q1[n] = (f32x4){0.f, 0.f, 0.f, 0.f}; q2[n] = (f32x4){0.f, 0.f, 0.f, 0.f}; }
#pragma unroll
            for (int m = 0; m < 4; ++m) {
                const int row = ROW_OF(ai, m);
                const float rs = __builtin_amdgcn_rsqf(rsv[ai][m] * (1.0f / D) + EPS);
                f32x4 o[2];
#pragma unroll
                for (int n = 0; n < 2; ++n) {
                    const f32x4 gv = acc[ai][0][m][n] * rs, vv = acc[ai][1][m][n] * rs;
                    f32x4 r1, r2;
#pragma unroll
                    for (int j = 0; j < 4; ++j) { r1[j] = __shfl(gv[j], src1); r2[j] = __shfl(gv[j], src2); }
                    f32x4 p1, p2;
#pragma unroll
                    for (int j = 0; j < 4; ++j) { p1[j] = fr >= 1 ? r1[j] : q1[n][j]; p2[j] = fr >= 2 ? r2[j] : q2[n][j]; }
                    q1[n] = r1; q2[n] = r2;
                    const f32x4 cv = bb[n] + w0[n] * p2 + w1[n] * p1 + w2[n] * gv;
                    o[n] = gelu4(cv) * vv;
                    if (m == 0 && fr < 2) { const size_t so = ((size_t)blk * 2 + fr) * FF + f0 + 4 * n; *(f32x4*)(headg + so) = gv; *(f32x4*)(headv + so) = vv; }
                    if (m == 3 && fr >= 14) { const size_t so = ((size_t)blk * 2 + (fr - 14)) * FF + f0 + 4 * n; *(f32x4*)(tailg + so) = gv; }
                }
                if (!(m == 0 && fr < 2)) {
                    u32x4 w; w.x = cvt_pk_bf16(o[0][0], o[0][1]); w.y = cvt_pk_bf16(o[0][2], o[0][3]); w.z = cvt_pk_bf16(o[1][0], o[1][1]); w.w = cvt_pk_bf16(o[1][2], o[1][3]);
                    *(u32x4*)(act + (size_t)row * FF + f0) = w;
                }
            }
        }
    }
};

__device__ __forceinline__ void tr_tile(const float* src, int ldw, const float* ksc, bf16_t* dst, int ldd, LAS float* scr, int lane) {
    float v[32];
#pragma unroll
    for (int i = 0; i < 32; ++i) v[i] = src[(size_t)(2 * i + (lane >> 5)) * ldw + (lane & 31)];
#pragma unroll
    for (int i = 0; i < 32; ++i) scr[(2 * i + (lane >> 5)) * 33 + (lane & 31)] = v[i];
    LDS_WAIT();
    const int c = lane & 7;
    f32x4 k0 = (f32x4){1.f, 1.f, 1.f, 1.f}, k1 = k0;
    if (ksc) { k0 = *(const f32x4*)(ksc + 8 * c); k1 = *(const f32x4*)(ksc + 8 * c + 4); }
#pragma unroll
    for (int j = 0; j < 4; ++j) { const int n = (lane >> 3) + 8 * j; const LAS float* s = scr + (8 * c) * 33 + n;
        u32x4 o; o.x = cvt_pk_bf16(s[0 * 33] * k0[0], s[1 * 33] * k0[1]); o.y = cvt_pk_bf16(s[2 * 33] * k0[2], s[3 * 33] * k0[3]);
        o.z = cvt_pk_bf16(s[4 * 33] * k1[0], s[5 * 33] * k1[1]); o.w = cvt_pk_bf16(s[6 * 33] * k1[2], s[7 * 33] * k1[3]);
        *(u32x4*)(dst + (size_t)n * ldd + 8 * c) = o; }
    LDS_WAIT();
}
__device__ __forceinline__ void tr_plain(const float* W, int K, int N, const float* ksc, bf16_t* WT, int item, LAS float* scr, int lane) {
    const int nblk = N / 32, kb = item / nblk, nb = item % nblk, k0 = kb * 64, n0 = nb * 32;
    tr_tile(W + (size_t)k0 * N + n0, N, ksc ? ksc + k0 : nullptr, WT + (size_t)n0 * K + k0, K, scr, lane);
}


#define UNPK8(q, f) const float f[8] = {bf_lo((q).x), bf_hi((q).x), bf_lo((q).y), bf_hi((q).y), bf_lo((q).z), bf_hi((q).z), bf_lo((q).w), bf_hi((q).w)}
template <int W> __device__ __forceinline__ void pool_run(const bf16_t* up, bf16_t* dp, int t0) {
    u32x4 q[W + 15];
#pragma unroll
    for (int i = 0; i < W + 15; ++i) { const int dt = i - (W - 1); const bool ok = (t0 + dt >= 0); const u32x4 v = *(const u32x4*)(up + (ptrdiff_t)(ok ? dt : 0) * PW); q[i] = ok ? v : (u32x4){0u, 0u, 0u, 0u}; }
    float s[8];
#pragma unroll
    for (int e = 0; e < 8; ++e) s[e] = 0.f;
#pragma unroll
    for (int i = 0; i < W - 1; ++i) { UNPK8(q[i], f);
#pragma unroll
        for (int e = 0; e < 8; ++e) s[e] += f[e]; }
#pragma unroll
    for (int j = 0; j < 16; ++j) {
        UNPK8(q[j + W - 1], cur);
#pragma unroll
        for (int e = 0; e < 8; ++e) s[e] += cur[e];
        const int cnt = (t0 + j + 1) < W ? (t0 + j + 1) : W; const float inv = 1.0f / (float)cnt;
        u32x4 o; o.x = cvt_pk_bf16(s[0] * inv - cur[0], s[1] * inv - cur[1]); o.y = cvt_pk_bf16(s[2] * inv - cur[2], s[3] * inv - cur[3]);
        o.z = cvt_pk_bf16(s[4] * inv - cur[4], s[5] * inv - cur[5]); o.w = cvt_pk_bf16(s[6] * inv - cur[6], s[7] * inv - cur[7]);
        *(u32x4*)(dp + (size_t)j * PW) = o;
        UNPK8(q[j], old);
#pragma unroll
        for (int e = 0; e < 8; ++e) s[e] -= old[e];
    }
}

struct Args { const float* in[22]; float* out; unsigned char* ws; };
#ifndef PH_MASK
#define PH_MASK 0xFFFF
#endif
#define PH(k) if constexpr ((PH_MASK >> (k)) & 1)
#ifndef REP_MASK
#define REP_MASK 0
#endif
#define REPS(k) for (int rep_ = 0; rep_ < 1 + ((REP_MASK >> (k)) & 1); ++rep_)

__global__ void __launch_bounds__(NTHR, 2) hybrid_block_fwd(Args a) {
    extern __shared__ __attribute__((aligned(16))) unsigned char lds_raw[];
    LAS unsigned char* lds = (LAS unsigned char*)lds_raw;
    cg::grid_group grid = cg::this_grid();
#define IDS() int tid = threadIdx.x; asm volatile("" : "+v"(tid)); const int lane = tid & 63, wave = __builtin_amdgcn_readfirstlane(tid >> 6); const int gtid = blockIdx.x * NTHR + tid, gw = blockIdx.x * (NTHR / 64) + wave; LAS float* scr = (LAS float*)(lds + wave * 16384); (void)lane; (void)gtid; (void)gw; (void)scr;
    unsigned char* ws = a.ws;
    volatile LAS unsigned* MISC = (volatile LAS unsigned*)(lds + 131072);
    if (threadIdx.x < 64) MISC[threadIdx.x] = 0u;
    unsigned* BARW = (unsigned*)(ws + WS_BAR);
    unsigned* PCNT = (unsigned*)(ws + WS_CNT);
    __syncthreads();
    if (ws == nullptr) grid.sync();
    const XcdBarrier xbar = xcd_barrier_post(BARW, MISC + 8);
    const float* x = a.in[0]; const float* g_mix = a.in[1]; const float* w_in = a.in[2]; const float* b_gate = a.in[3];
    const float* w_pool = a.in[4]; const float* pool_scale = a.in[5]; const float* lru_conv_w = a.in[6]; const float* lru_conv_b = a.in[7];
    const float* w_a = a.in[8]; const float* b_a = a.in[9]; const float* w_i = a.in[10]; const float* b_i = a.in[11]; const float* lru_lambda = a.in[12];
    const float* w_pool_proj = a.in[13]; const float* w_lru_proj = a.in[14]; const float* w_out = a.in[15]; const float* g_mlp = a.in[16];
    const float* w_up = a.in[17]; const float* ffn_conv_w = a.in[18]; const float* ffn_conv_b = a.in[19]; const float* w_down = a.in[20]; const float* g_final = a.in[21];
    float* out = a.out;
    float* RSTD1 = (float*)(ws + WS_RSTD1); float* SS2 = (float*)(ws + WS_SS2); float* SS3 = (float*)(ws + WS_SS3); float* SP8 = (float*)(ws + WS_SP8);
    float* AGGP = (float*)(ws + WS_AGGP); float* AGGH = (float*)(ws + WS_AGGH);
    bf16_t* WT_POOL = (bf16_t*)(ws + WS_WT_POOL); bf16_t* WT_GATE = (bf16_t*)(ws + WS_WT_GATE); bf16_t* WT_CAT = (bf16_t*)(ws + WS_WT_PP);
    bf16_t* WT_OUT = (bf16_t*)(ws + WS_WT_OUT); bf16_t* WT_IN = (bf16_t*)(ws + WS_WT_IN);
    bf16_t* WT_UP = (bf16_t*)(ws + WS_WT_UP); bf16_t* WT_DOWN = (bf16_t*)(ws + WS_WT_DOWN);
    bf16_t* XB = (bf16_t*)(ws + WS_XB); bf16_t* DD = (bf16_t*)(ws + WS_DD); bf16_t* VV = (bf16_t*)(ws + WS_V2); float* HEADU = (float*)(ws + WS_HEADU); float* TAILU = (float*)(ws + WS_TAILU); bf16_t* YCAT = (bf16_t*)(ws + WS_YCAT);
    bf16_t* UPOOL = (bf16_t*)(ws + WS_UPOOL); bf16_t* GELU_U = (bf16_t*)(ws + WS_GELU); bf16_t* X1B = (bf16_t*)(ws + WS_X1B);
    bf16_t* GATES = (bf16_t*)(ws + WS_GATES); bf16_t* ULRU = (bf16_t*)(ws + WS_ULRU); bf16_t* BX = (bf16_t*)(ws + WS_BX); bf16_t* MERGED = (bf16_t*)(ws + WS_MERGED);
    bf16_t* ACT = (bf16_t*)(ws + WS_ACT); float* TAILG = (float*)(ws + WS_TAILG); float* HEADG = (float*)(ws + WS_HEADG); float* HEADV = (float*)(ws + WS_HEADV);
    float* AF = out;

    PH(0) REPS(0) { IDS();
    for (int i = gtid; i < 2 * M; i += NT) SS2[i] = 0.f;
    for (int i = gtid; i < LW; i += NT) SP8[i] = 8.0f * log1pf(expf(-lru_lambda[i]));
    {
        constexpr int I_IN = (D / 64) * (INW / 32), I_PP = (PW / 64) * (D / 32), I_LP = (LW / 64) * (D / 32), I_OUT = (D / 64) * (D / 32), I_POOL = 4 * 4 * 8, I_GATE = 4 * 128;
        constexpr int NITEMS = I_IN + I_PP + I_LP + I_OUT + I_POOL + I_GATE;
        for (int it = gw; it < NITEMS; it += NWV) {
            int r = it;
            if (r < I_IN) { tr_plain(w_in, D, INW, g_mix, WT_IN, r, scr, lane); continue; } r -= I_IN;
            if (r < I_PP) { const int kb = r / (D / 32), nb = r % (D / 32); tr_tile(w_pool_proj + (size_t)kb * 64 * D + nb * 32, D, nullptr, WT_CAT + (size_t)nb * 32 * KC + kb * 64, KC, scr, lane); continue; } r -= I_PP;
            if (r < I_LP) { const int kb = r / (D / 32), nb = r % (D / 32); tr_tile(w_lru_proj + (size_t)kb * 64 * D + nb * 32, D, nullptr, WT_CAT + (size_t)nb * 32 * KC + PW + kb * 64, KC, scr, lane); continue; } r -= I_LP;
            if (r < I_OUT) { tr_plain(w_out, D, D, nullptr, WT_OUT, r, scr, lane); continue; } r -= I_OUT;
            if (r < I_POOL) { const int g = r >> 5; tr_plain(w_pool + (size_t)g * 65536, 256, 256, nullptr, WT_POOL + (size_t)g * 65536, r & 31, scr, lane); continue; } r -= I_POOL;
            {
                const int kb = r >> 7, nb = r & 127, n0 = nb * 32, pn = n0 >> 8, bj = (n0 >> 7) & 1, j0 = n0 & 127, k0 = kb * 64;
                const float* W = (bj ? w_i : w_a) + (size_t)(pn >> 1) * 65536;
                tr_tile(W + (size_t)k0 * 256 + (pn & 1) * 128 + j0, 256, nullptr, WT_GATE + (size_t)n0 * 256 + k0, 256, scr, lane);
            }
        }
        for (int row = gw; row < M; row += NWV) {
            const f32x4* xr = (const f32x4*)(x + (size_t)row * D) + lane; f32x4 v[8]; float s = 0.f;
#pragma unroll
            for (int j = 0; j < 8; ++j) { v[j] = xr[64 * j]; s += (v[j][0] * v[j][0] + v[j][1] * v[j][1]) + (v[j][2] * v[j][2] + v[j][3] * v[j][3]); }
            s = wave_sum(s);
            const float nrm1 = sqrtf(s * (1.0f / D) + EPS), rs1 = 1.0f / nrm1;
            if (lane == 0) RSTD1[row] = nrm1;
            u32x2* o = (u32x2*)(XB + (size_t)row * D) + lane;
#pragma unroll
            for (int j = 0; j < 8; ++j) { u32x2 w; w.x = cvt_pk_bf16(v[j][0] * rs1, v[j][1] * rs1); w.y = cvt_pk_bf16(v[j][2] * rs1, v[j][3] * rs1); o[64 * j] = w; }
        }
    }
    }
    xcd_barrier(xbar);

    PH(1) REPS(1)
    {
        pg8::Gemm g{XB, WT_IN, D, D, 0}; pg8::Order2D S; S.init(M, INW, (int)blockIdx.x);
        EpiProj E{SS2, b_gate, UPOOL, ULRU, GELU_U, GATES, lru_conv_w, lru_conv_b, VV, HEADU, TAILU};
        pg8::gemm_phase(lds, g, S, E);
    }
    xcd_barrier(xbar);

    PH(2) REPS(2)
    { IDS();
        {
            const int grp = __builtin_amdgcn_readfirstlane(gtid >> 15), run = (gtid >> 5) & 1023, c = grp * 256 + (gtid & 31) * 8, r0 = run * 16, t0 = r0 & (SEQ - 1);
            const bf16_t* up = UPOOL + (size_t)r0 * PW + c; bf16_t* dp = DD + (size_t)r0 * PW + c;
            if (grp == 0) pool_run<2>(up, dp, t0); else if (grp == 1) pool_run<4>(up, dp, t0); else if (grp == 2) pool_run<8>(up, dp, t0); else pool_run<16>(up, dp, t0);
        }
        for (int idx = gtid; idx < 256 * 3 * (LW / 4); idx += NT) {
            const int c4 = (idx % (LW / 4)) * 4, rr = (idx / (LW / 4)) % 3, blk = idx / (3 * (LW / 4));
            const bool seq0 = (blk & 127) == 0; const int pb = seq0 ? blk : blk - 1; const size_t row = (size_t)blk * 64 + rr;
            const float* H = HEADU + (size_t)blk * 3 * LW + c4; const float* T = TAILU + (size_t)pb * 3 * LW + c4;
            const f32x4 z = (f32x4){0.f, 0.f, 0.f, 0.f};
            const f32x4 t0 = *(const f32x4*)(T), t1 = *(const f32x4*)(T + LW), t2 = *(const f32x4*)(T + 2 * LW);
            const f32x4 h0 = *(const f32x4*)(H), h1 = *(const f32x4*)(H + (rr >= 1 ? LW : 0)), h2 = *(const f32x4*)(H + (rr >= 2 ? 2 * LW : 0));
            const f32x4 T0 = seq0 ? z : t0, T1 = seq0 ? z : t1, T2 = seq0 ? z : t2;
            const f32x4 u0 = rr == 0 ? h0 : (rr == 1 ? h1 : h2);
            const f32x4 u1 = rr == 0 ? T2 : (rr == 1 ? h0 : h1);
            const f32x4 u2 = rr == 0 ? T1 : (rr == 1 ? T2 : h0);
            const f32x4 u3 = rr == 0 ? T0 : (rr == 1 ? T1 : T2);
            const f32x4 v = *(const f32x4*)(lru_conv_b + c4) + *(const f32x4*)(lru_conv_w + c4) * u3 + *(const f32x4*)(lru_conv_w + LW + c4) * u2 + *(const f32x4*)(lru_conv_w + 2 * LW + c4) * u1 + *(const f32x4*)(lru_conv_w + 3 * LW + c4) * u0;
            u32x2 w; w.x = cvt_pk_bf16(v[0], v[1]); w.y = cvt_pk_bf16(v[2], v[3]);
            *(u32x2*)(VV + row * LW + c4) = w;
        }
    }
    xcd_barrier(xbar);

    PH(3) REPS(3)
    {
        { pg8::Gemm g{DD, WT_POOL, PW, 256, 1}; pg8::StaticOrder S; S.init(M, PW, NWG, (int)blockIdx.x);
          EpiPool E{pool_scale, YCAT}; pg8::gemm_phase(lds, g, S, E); }
        { pg8::Gemm g{VV, WT_GATE, LW, 256, 2}; pg8::StaticOrder S; S.init(M, 2 * LW, NWG, (int)blockIdx.x);
          EpiLru E{VV, b_a, b_i, SP8, (unsigned*)AF}; pg8::gemm_phase(lds, g, S, E); }
    }
    xcd_barrier(xbar);

    PH(4) REPS(4)
    { IDS();
        const int c2 = gtid & 1023, chunk = (gtid >> 10) & (NCH - 1), b = gtid >> 16;
        const size_t r0 = (size_t)b * SEQ + (size_t)chunk * CH_L;
        const u32x2* pab = (const u32x2*)((const unsigned*)AF + r0 * LW) + c2;
        f32x2 P = (f32x2){1.f, 1.f}, H = (f32x2){0.f, 0.f};
#pragma unroll 32
        for (int i = 0; i < CH_L; ++i) { const u32x2 q = pab[(size_t)i * (LW / 2)];
            const f32x2 av = (f32x2){__builtin_amdgcn_exp2f(bf_lo(q.x)), __builtin_amdgcn_exp2f(bf_lo(q.y))}, bv = (f32x2){bf_hi(q.x), bf_hi(q.y)}; P = P * av; H = av * H + bv; }
        ((f32x2*)(AGGP + (size_t)(b * NCH + chunk) * LW))[c2] = P; ((f32x2*)(AGGH + (size_t)(b * NCH + chunk) * LW))[c2] = H;
    }
    xcd_barrier(xbar);

    PH(5) REPS(5)
    { IDS();
        const int c2 = gtid & 1023, chunk = (gtid >> 10) & (NCH - 1), b = gtid >> 16;
        f32x2 H = (f32x2){0.f, 0.f};
#pragma unroll 4
        for (int j = 0; j < chunk; ++j) { const f32x2 P = ((const f32x2*)(AGGP + (size_t)(b * NCH + j) * LW))[c2], Hj = ((const f32x2*)(AGGH + (size_t)(b * NCH + j) * LW))[c2]; H = P * H + Hj; }
        const size_t r0 = (size_t)b * SEQ + (size_t)chunk * CH_L;
        const u32x2* pab = (const u32x2*)((const unsigned*)AF + r0 * LW) + c2;
        const unsigned* pg = (const unsigned*)(GELU_U + r0 * LW) + c2; unsigned* po = (unsigned*)(YCAT + r0 * KC + PW) + c2;
#pragma unroll 16
        for (int i = 0; i < CH_L; ++i) {
            const u32x2 q = pab[(size_t)i * (LW / 2)]; const f32x2 av = (f32x2){__builtin_amdgcn_exp2f(bf_lo(q.x)), __builtin_amdgcn_exp2f(bf_lo(q.y))}, bv = (f32x2){bf_hi(q.x), bf_hi(q.y)}; const unsigned gq = pg[(size_t)i * (LW / 2)];
            H = av * H + bv;
            po[(size_t)i * (KC / 2)] = cvt_pk_bf16(H.x * bf_lo(gq), H.y * bf_hi(gq));
        }
    }
    xcd_barrier(xbar);

    PH(6) REPS(6)
    {
        pg8::StaticOrder S; S.init(M, D, NWG, (int)blockIdx.x);
        { pg8::Gemm g{YCAT, WT_CAT, KC, KC, 0}; EpiMerge E{(const unsigned char*)GATES, MERGED}; pg8::gemm_phase(lds, g, S, E); }
    }
    xcd_barrier(xbar);

    PH(7) REPS(7)
    { IDS();
        { pg8::Gemm g{MERGED, WT_OUT, D, D, 0}; pg8::StaticOrder S; S.init(M, D, NWG, (int)blockIdx.x);
          EpiResid1 E{XB, RSTD1, X1B, SS2}; pg8::gemm_phase(lds, g, S, E); }
        constexpr int I_UP = (D / 64) * (2 * FF / 32), I_DOWN = (FF / 64) * (D / 32);
        for (int rep2_ = 0; rep2_ < 1 + ((REP_MASK >> 12) & 1); ++rep2_)
        for (int it = gw; it < I_UP + I_DOWN; it += NWV) {
            if (it < I_UP) {
                const int nblk = 2 * FF / 32, kb = it / nblk, nb = it % nblk, n0 = nb * 32, pn = n0 >> 8, bj = (n0 >> 7) & 1, j0 = n0 & 127, k0 = kb * 64;
                tr_tile(w_up + (size_t)k0 * (2 * FF) + bj * FF + pn * 128 + j0, 2 * FF, g_mlp + k0, WT_UP + (size_t)n0 * D + k0, D, scr, lane);
            } else tr_plain(w_down, FF, D, nullptr, WT_DOWN, it - I_UP, scr, lane);
        }
    }
    xcd_barrier(xbar);

    PH(8) REPS(8)
    {
        pg8::Gemm g{X1B, WT_UP, D, D, 0}; pg8::Order2D S; S.init(M, 2 * FF, (int)blockIdx.x);
        EpiUp E{SS2, ffn_conv_w, ffn_conv_b, ACT, TAILG, HEADG, HEADV}; pg8::gemm_phase(lds, g, S, E);
    }
    xcd_barrier(xbar);

    PH(9) REPS(9)
    { IDS();
        for (int idx = gtid; idx < 256 * 2 * (FF / 4); idx += NT) {
            const int f4 = (idx % (FF / 4)) * 4, rr = (idx / (FF / 4)) & 1, blk = idx / (2 * (FF / 4));
            const bool seq0 = (blk & 127) == 0; const size_t row = (size_t)blk * 64 + rr;
            const f32x4 z = (f32x4){0.f, 0.f, 0.f, 0.f};
            const f32x4 gc = *(const f32x4*)(HEADG + ((size_t)blk * 2 + rr) * FF + f4), vv = *(const f32x4*)(HEADV + ((size_t)blk * 2 + rr) * FF + f4);
            f32x4 p1, p2;
            if (rr == 0) { p1 = seq0 ? z : *(const f32x4*)(TAILG + ((size_t)(blk - 1) * 2 + 1) * FF + f4); p2 = seq0 ? z : *(const f32x4*)(TAILG + ((size_t)(blk - 1) * 2 + 0) * FF + f4); }
            else { p1 = *(const f32x4*)(HEADG + ((size_t)blk * 2 + 0) * FF + f4); p2 = seq0 ? z : *(const f32x4*)(TAILG + ((size_t)(blk - 1) * 2 + 1) * FF + f4); }
            const f32x4 cv = *(const f32x4*)(ffn_conv_b + f4) + *(const f32x4*)(ffn_conv_w + f4) * p2 + *(const f32x4*)(ffn_conv_w + FF + f4) * p1 + *(const f32x4*)(ffn_conv_w + 2 * FF + f4) * gc;
            u32x2 w; w.x = cvt_pk_bf16(gelu_tanh(cv[0]) * vv[0], gelu_tanh(cv[1]) * vv[1]); w.y = cvt_pk_bf16(gelu_tanh(cv[2]) * vv[2], gelu_tanh(cv[3]) * vv[3]);
            *(u32x2*)(ACT + row * FF + f4) = w;
        }
    }
    xcd_barrier(xbar);

    PH(10) REPS(10)
    {
        pg8::Gemm g{ACT, WT_DOWN, FF, FF, 0}; pg8::PanelOrder S{(int)blockIdx.x};
        EpiFinal E{X1B, SS3, PCNT, g_final, out}; pg8::gemm_phase(lds, g, S, E);
    }
}

extern "C" void kernel_launch(void* const* d_in, const int* in_sizes, int n_in, void* d_out, int out_size, void* d_ws, size_t ws_size, hipStream_t stream) {
    static int grid = 0;
    if (grid == 0) {
        if (n_in != 22 || in_sizes[0] != M * D || out_size != M * D || ws_size < WS_END) {
            fprintf(stderr, "kernel_launch: unexpected shapes: n_in %d in0 %d out %d ws %zu (need >= %zu)\n", n_in, n_in > 0 ? in_sizes[0] : -1, out_size, ws_size, (size_t)WS_END); grid = -1; return; }
        int dev = 0, cus = 0, per_cu = 0;
        hipGetDevice(&dev); hipDeviceGetAttribute(&cus, hipDeviceAttributeMultiprocessorCount, dev);
        if (hipFuncSetAttribute((const void*)hybrid_block_fwd, hipFuncAttributeMaxDynamicSharedMemorySize, LDS_BYTES) != hipSuccess) { fprintf(stderr, "kernel_launch: hipFuncSetAttribute failed\n"); grid = -1; return; }
        hipOccupancyMaxActiveBlocksPerMultiprocessor(&per_cu, (const void*)hybrid_block_fwd, NTHR, LDS_BYTES);
        (void)hipGetLastError();
        if (cus != NWG || per_cu < 1) fprintf(stderr, "kernel_launch: note: cus %d per_cu %d (kernel is built for a 256-workgroup grid)\n", cus, per_cu);
        grid = NWG;
    }
    if (grid < 0) return;
    if (hipMemsetAsync((char*)d_ws + WS_BAR, 0, (WS_CNT - WS_BAR) + 256, stream) != hipSuccess) { fprintf(stderr, "kernel_launch: hipMemsetAsync failed\n"); return; }
    Args a{};
    for (int i = 0; i < 22; ++i) a.in[i] = (const float*)d_in[i];
    a.out = (float*)d_out; a.ws = (unsigned char*)d_ws;
    void* args[] = {&a};
    hipError_t e = hipLaunchCooperativeKernel((const void*)hybrid_block_fwd, dim3(grid), dim3(NTHR), args, LDS_BYTES, stream);
    if (e != hipSuccess) fprintf(stderr, "kernel_launch: cooperative launch failed: %s\n", hipGetErrorString(e));
}
```
